# Optimizing an MI355X kernel written in HIP

```python
import jax, jax.numpy as jnp
from jax import lax
import numpy as np

D_MODEL = 1024
BATCH = 8
SEQ = 4096
DEPTH = 2

HEAD_DIM = 64
ROPE_THETA = 10000.0
NORM_EPS = 1e-6
BLOCK = 128

A_HEADS = 6
IDX_HEADS = 8
IDX_DIM = 64
TOPK_MAX = 256

B_GROUPS = ((128, 1), (512, 4), (2048, 16))
B_HEADS_PER_GROUP = 4
B_HEADS = B_HEADS_PER_GROUP * len(B_GROUPS)

C_HEADS = 8
C_KV_HEADS = 2
C_WINDOW = 128

N_BRANCHES = 3
D_FF = 4 * D_MODEL

IN_WIDTHS = (A_HEADS * HEAD_DIM, HEAD_DIM, HEAD_DIM,
             IDX_HEADS * IDX_DIM, IDX_DIM, IDX_HEADS,
             B_HEADS * HEAD_DIM, B_HEADS * HEAD_DIM, B_HEADS * HEAD_DIM,
             C_HEADS * HEAD_DIM, C_KV_HEADS * HEAD_DIM, C_KV_HEADS * HEAD_DIM,
             N_BRANCHES * D_MODEL)
IN_WIDTH = sum(IN_WIDTHS)

kernel_name = "hybrid_gated_dsa_dilated_sinkswa"


def rmsnorm(x, g):
    xf = x.astype(jnp.float32)
    y = xf * lax.rsqrt(jnp.mean(xf * xf, axis=-1, keepdims=True) + NORM_EPS)
    return (y * g.astype(jnp.float32)).astype(x.dtype)


def rope(x, pos):
    half = x.shape[-1] // 2
    inv = ROPE_THETA ** (-jnp.arange(half, dtype=jnp.float32) / half)
    ang = pos.astype(jnp.float32)[..., None] * inv
    cos = jnp.cos(ang)[:, :, None, :].astype(x.dtype)
    sin = jnp.sin(ang)[:, :, None, :].astype(x.dtype)
    x1, x2 = x[..., :half], x[..., half:]
    return jnp.concatenate([x1 * cos - x2 * sin, x2 * cos + x1 * sin], axis=-1)


def split_columns(z):
    parts, off = [], 0
    for w in IN_WIDTHS:
        parts.append(z[..., off:off + w])
        off += w
    return parts


def over_query_blocks(fn, seq_len):
    starts = jnp.arange(seq_len // BLOCK, dtype=jnp.int32) * BLOCK
    out = lax.map(fn, starts)
    out = jnp.moveaxis(out, 0, 1)
    return out.reshape(out.shape[0], seq_len, *out.shape[3:])


def dsa_attention(q, k, v, iq, ik, iw):
    L = q.shape[1]
    topk = min(TOPK_MAX, L // 4)
    scale = HEAD_DIM ** -0.5
    idx_scale = IDX_DIM ** -0.5
    s_all = jnp.arange(L)

    def block(t0):
        t = t0 + jnp.arange(BLOCK)
        qb = lax.dynamic_slice_in_dim(q, t0, BLOCK, 1)
        iqb = lax.dynamic_slice_in_dim(iq, t0, BLOCK, 1)
        iwb = lax.dynamic_slice_in_dim(iw, t0, BLOCK, 1).astype(jnp.float32)
        rel = jax.nn.relu(jnp.einsum('bqhd,bsd->bqhs', iqb, ik).astype(jnp.float32) * idx_scale)
        score = jnp.einsum('bqh,bqhs->bqs', iwb, rel)
        causal = s_all[None, :] <= t[:, None]
        score = jnp.where(causal[None], score, -jnp.inf)
        _, idx = lax.top_k(score, topk)
        ks = jax.vmap(lambda kk, ii: kk[ii])(k, idx)
        vs = jax.vmap(lambda vv, ii: vv[ii])(v, idx)
        valid = idx <= t[None, :, None]
        logits = jnp.einsum('bqhd,bqkd->bqhk', qb, ks).astype(jnp.float32) * scale
        logits = jnp.where(valid[:, :, None, :], logits, -jnp.inf)
        p = jax.nn.softmax(logits, axis=-1)
        return jnp.einsum('bqhk,bqkd->bqhd', p.astype(vs.dtype), vs)

    return over_query_blocks(block, L)


def dilated_attention(q, k, v):
    L = q.shape[1]
    scale = HEAD_DIM ** -0.5
    hg = B_HEADS_PER_GROUP
    qs = [q[:, :, g * hg:(g + 1) * hg] for g in range(len(B_GROUPS))]
    kss = [k[:, :, g * hg:(g + 1) * hg] for g in range(len(B_GROUPS))]
    vss = [v[:, :, g * hg:(g + 1) * hg] for g in range(len(B_GROUPS))]

    def block(t0):
        t = t0 + jnp.arange(BLOCK)
        outs, lses = [], []
        for g, (window, dil) in enumerate(B_GROUPS):
            qb = lax.dynamic_slice_in_dim(qs[g], t0, BLOCK, 1)
            pos = t[:, None] - dil * jnp.arange(window // dil + 1)[None, :]
            valid = pos >= 0
            pos_c = jnp.maximum(pos, 0)
            kg = kss[g][:, pos_c]
            vg = vss[g][:, pos_c]
            logits = jnp.einsum('bqhd,bqkhd->bqhk', qb, kg).astype(jnp.float32) * scale
            logits = jnp.where(valid[None, :, None, :], logits, -jnp.inf)
            m = jnp.max(logits, axis=-1, keepdims=True)
            e = jnp.exp(logits - m)
            den = jnp.sum(e, axis=-1)
            o = jnp.einsum('bqhk,bqkhd->bqhd', (e / den[..., None]).astype(vg.dtype), vg)
            outs.append(o)
            lses.append(m[..., 0] + jnp.log(den))
        alpha = jax.nn.softmax(jnp.stack(lses, 0), axis=0)
        return jnp.einsum('gbqh,gbqhd->bqhd', alpha.astype(outs[0].dtype), jnp.stack(outs, 0))

    return over_query_blocks(block, L)


def sink_window_attention(q, k, v, sinks):
    Bsz, L = q.shape[0], q.shape[1]
    grp = C_HEADS // C_KV_HEADS
    scale = HEAD_DIM ** -0.5
    pad = ((0, 0), (BLOCK, 0), (0, 0), (0, 0))
    kp = jnp.pad(k, pad)
    vp = jnp.pad(v, pad)
    qg = q.reshape(Bsz, L, C_KV_HEADS, grp, HEAD_DIM)
    sink = sinks.astype(jnp.float32).reshape(C_KV_HEADS, grp)[:, :, None, None]

    def block(t0):
        t = t0 + jnp.arange(BLOCK)
        s = t0 - BLOCK + jnp.arange(2 * BLOCK)
        qb = lax.dynamic_slice_in_dim(qg, t0, BLOCK, 1)
        kb = lax.dynamic_slice_in_dim(kp, t0, 2 * BLOCK, 1)
        vb = lax.dynamic_slice_in_dim(vp, t0, 2 * BLOCK, 1)
        mask = (s[None, :] <= t[:, None]) & (s[None, :] > t[:, None] - C_WINDOW) & (s[None, :] >= 0)
        logits = jnp.einsum('bqkgd,bskd->bkgqs', qb, kb).astype(jnp.float32) * scale
        logits = jnp.where(mask, logits, -jnp.inf)
        m = jnp.maximum(jnp.max(logits, axis=-1, keepdims=True), sink)
        e = jnp.exp(logits - m)
        den = jnp.sum(e, axis=-1, keepdims=True) + jnp.exp(sink - m)
        p = (e / den).astype(vb.dtype)
        o = jnp.einsum('bkgqs,bskd->bqkgd', p, vb)
        return o.reshape(Bsz, BLOCK, C_HEADS, HEAD_DIM)

    return over_query_blocks(block, L)


def hybrid_mixer(u, pos, w_in, idx_k_norm, sinks, w_a, w_b, w_c, w_o):
    Bsz, L, _ = u.shape
    (aq, ak, av, iq, ik, iw, bq, bk, bv, cq, ck, cv, gates) = split_columns(u @ w_in)
    qa = rope(aq.reshape(Bsz, L, A_HEADS, HEAD_DIM), pos)
    ka = rope(ak[:, :, None, :], pos)[:, :, 0]
    iqr = rope(iq.reshape(Bsz, L, IDX_HEADS, IDX_DIM), pos)
    ikr = rope(rmsnorm(ik, idx_k_norm)[:, :, None, :], pos)[:, :, 0]
    o_a = dsa_attention(qa, ka, av, iqr, ikr, iw * IDX_HEADS ** -0.5)
    o_b = dilated_attention(rope(bq.reshape(Bsz, L, B_HEADS, HEAD_DIM), pos),
                            rope(bk.reshape(Bsz, L, B_HEADS, HEAD_DIM), pos),
                            bv.reshape(Bsz, L, B_HEADS, HEAD_DIM))
    o_c = sink_window_attention(rope(cq.reshape(Bsz, L, C_HEADS, HEAD_DIM), pos),
                                rope(ck.reshape(Bsz, L, C_KV_HEADS, HEAD_DIM), pos),
                                cv.reshape(Bsz, L, C_KV_HEADS, HEAD_DIM), sinks)
    g = jax.nn.sigmoid(gates.reshape(Bsz, L, N_BRANCHES, D_MODEL))
    merged = (g[:, :, 0] * (o_a.reshape(Bsz, L, -1) @ w_a)
              + g[:, :, 1] * (o_b.reshape(Bsz, L, -1) @ w_b)
              + g[:, :, 2] * (o_c.reshape(Bsz, L, -1) @ w_c))
    return merged @ w_o


def setup_inputs(seed: int = 0) -> dict:
    key = jax.random.key(seed)
    ks = jax.random.split(key, 15)

    def normal(k, shape, scale):
        return jax.random.normal(k, shape, jnp.float32) * scale

    def gain(k, shape):
        return 1.0 + 0.05 * jax.random.normal(k, shape, jnp.float32)

    x = normal(ks[0], (BATCH, SEQ, D_MODEL), 1.0)
    positions = jnp.tile(jnp.arange(SEQ, dtype=jnp.int32)[None, :], (BATCH, 1))
    return {
        "x": x,
        "positions": positions,
        "attn_norm": gain(ks[1], (DEPTH, D_MODEL)),
        "w_in": normal(ks[2], (DEPTH, D_MODEL, IN_WIDTH), D_MODEL ** -0.5),
        "idx_k_norm": gain(ks[3], (DEPTH, IDX_DIM)),
        "sinks": normal(ks[4], (DEPTH, C_HEADS), 0.5),
        "w_a": normal(ks[5], (DEPTH, A_HEADS * HEAD_DIM, D_MODEL), (A_HEADS * HEAD_DIM) ** -0.5),
        "w_b": normal(ks[6], (DEPTH, B_HEADS_PER_GROUP * HEAD_DIM, D_MODEL), (B_HEADS_PER_GROUP * HEAD_DIM) ** -0.5),
        "w_c": normal(ks[7], (DEPTH, C_HEADS * HEAD_DIM, D_MODEL), (C_HEADS * HEAD_DIM) ** -0.5),
        "w_o": normal(ks[8], (DEPTH, D_MODEL, D_MODEL), D_MODEL ** -0.5),
        "mlp_norm": gain(ks[9], (DEPTH, D_MODEL)),
        "w_up": normal(ks[10], (DEPTH, D_MODEL, D_FF), D_MODEL ** -0.5),
        "w_down": normal(ks[11], (DEPTH, D_FF, D_MODEL), D_FF ** -0.5),
        "final_norm": gain(ks[12], (D_MODEL,)),
    }


def reference(x, positions, attn_norm, w_in, idx_k_norm, sinks, w_a, w_b, w_c, w_o,
              mlp_norm, w_up, w_down, final_norm):
    h = x
    for l in range(DEPTH):
        u = rmsnorm(h, attn_norm[l])
        h = h + hybrid_mixer(u, positions, w_in[l], idx_k_norm[l], sinks[l],
                             w_a[l], w_b[l], w_c[l], w_o[l])
        u = rmsnorm(h, mlp_norm[l])
        h = h + jnp.square(jax.nn.relu(u @ w_up[l])) @ w_down[l]
    return rmsnorm(h, final_norm)
```

```cpp
#include <hip/hip_runtime.h>
#include <cstdio>
#include <cstdint>
namespace pg8 {
#define PG8_LAS __attribute__((address_space(3)))
typedef unsigned short bf16_t;
typedef short bf16x8 __attribute__((ext_vector_type(8)));
typedef float f32x4 __attribute__((ext_vector_type(4)));
typedef unsigned u32x4 __attribute__((ext_vector_type(4)));
constexpr int BM = 256, BK = 64, HALF = 128, HTB = HALF * BK * 2  , STAGE_BYTES = 8 * HTB, NXCD = 8, WGM = 8;

__host__ __device__ __forceinline__ int lds_byte(int r, int c) { const int st = (r >> 4) * 2 + (c >> 5), rr = r & 15, cc = c & 31, ob = rr * 64 + cc * 2; return st * 1024 + (ob ^ (((ob >> 9) & 1) << 5)); }
__host__ __device__ __forceinline__ void stage_rc(int b, int& R, int& C) { const int st = b / 1024, sb = b % 1024, swz = sb ^ (((sb >> 9) & 1) << 5); R = (st >> 1) * 16 + swz / 64; C = (st & 1) * 32 + (swz % 64) / 2; }
__host__ __device__ __forceinline__ int perm32(int rho) { const int n = rho >> 4, i = rho & 15; return 8 * (i >> 2) + 4 * n + (i & 3); }

struct Unit { int pm, pn; };
struct Gemm { const bf16_t* A; const bf16_t* Bt; int M, N, K; };

struct StaticOrder {
    int nM, nN, nwg, G, c;
    __host__ __device__ void init(int M, int N, int G_, int c_) { nM = M / BM; nN = N / BM; nwg = nM * nN; G = G_; c = c_; }
    __host__ __device__ bool next(int i, Unit& u) const {
        const long L = (long)i * G + c; if (L >= nwg) return false;
        int wgid = (int)L; { const int q = nwg / NXCD, r = nwg % NXCD, xcd = wgid % NXCD, off = wgid / NXCD; wgid = (xcd < r ? xcd * (q + 1) : r * (q + 1) + (xcd - r) * q) + off; }
        const int nig = WGM * nN, gid = wgid / nig, fm = gid * WGM, gsz = (nM - fm) < WGM ? (nM - fm) : WGM;
        u.pm = fm + ((wgid % nig) % gsz); u.pn = (wgid % nig) / gsz; return true;
    }
    __device__ __forceinline__ void a_ready(const Unit&) const {}
    __device__ __forceinline__ void done(const Unit&) const {}
};

typedef float f32x2 __attribute__((ext_vector_type(2)));
typedef __bf16 bf16x2_t __attribute__((ext_vector_type(2)));
typedef _Float16 f16x2_t __attribute__((ext_vector_type(2)));
__device__ __forceinline__ unsigned pkbf(float lo, float hi) { f32x2 v = {lo, hi}; bf16x2_t b = __builtin_convertvector(v, bf16x2_t); return __builtin_bit_cast(unsigned, b); }
__device__ __forceinline__ unsigned pkh(float lo, float hi) { f32x2 v = {lo, hi}; f16x2_t b = __builtin_convertvector(v, f16x2_t); return __builtin_bit_cast(unsigned, b); }
__device__ __forceinline__ float bflo(unsigned u) { return __builtin_bit_cast(float, u << 16); }
__device__ __forceinline__ float bfhi(unsigned u) { return __builtin_bit_cast(float, u & 0xffff0000u); }
constexpr int DMODEL = 1024;
constexpr float NORM_EPS = 1e-6f;
constexpr float QSCALE = 0.125f * 1.4426950408889634f;

__device__ __forceinline__ float row_rs(const float* ssq, int row) {
    const f32x4* p = (const f32x4*)(ssq + (size_t)row * 16);
    const f32x4 a = p[0], b = p[1], c = p[2], d = p[3];
    const float s = ((a.x + a.y) + (a.z + a.w)) + ((b.x + b.y) + (b.z + b.w)) + ((c.x + c.y) + (c.z + c.w)) + ((d.x + d.y) + (d.z + d.w));
    return 1.0f / sqrtf(s * (1.0f / DMODEL) + NORM_EPS);
}

__device__ __forceinline__ void wave_row_rs(const float* ssq, int rowbase  , int fr, int fq, float (&rs)[2][4]) {
    const int ai0 = fq >> 1, m0 = 2 * (fq & 1);
    const float ra = row_rs(ssq, rowbase + ai0 * HALF + m0 * 16), rb = row_rs(ssq, rowbase + ai0 * HALF + (m0 + 1) * 16);
#pragma unroll
    for (int ai = 0; ai < 2; ++ai)
#pragma unroll
        for (int m = 0; m < 4; ++m) { const int src = fr + 16 * (2 * ai + (m >> 1)); rs[ai][m] = __shfl((m & 1) ? rb : ra, src); }
}

struct QkvBufs { bf16_t *aq, *ak, *av, *iq, *ik, *bq, *bk, *bv, *cq, *ck, *cv; float* iw; };
struct EpiQKV {
    static constexpr bool PERM = true, AFTER_DRAIN = false, KHOOK = false; static constexpr int HOOK_T0 = -1, HOOK_T1 = -1;
    QkvBufs B; const float* ssq; const f32x2* cs; const float* iknorm;
    __device__ __forceinline__ void operator()(const f32x4 (&acc)[2][2][4][2], const Unit& u_, int wr, int wc, int fr_, int fq_) const {
        Unit u = u_; int ln_ = (int)(threadIdx.x & 63u); asm volatile("" : "+s"(u.pm), "+s"(u.pn), "+v"(ln_)); const int fr = ln_ & 15, fq = ln_ >> 4;
        const int slot = u.pn * 4 + wc;
        if (slot >= 66) return;
        int kind, pitch; bf16_t* dst; float scale = 1.f;
        if (slot < 6)        { kind = 1; dst = B.aq + slot * 64; pitch = 384; scale = QSCALE; }
        else if (slot == 6)  { kind = 1; dst = B.ak; pitch = 64; }
        else if (slot == 7)  { kind = 0; dst = B.av; pitch = 64; }
        else if (slot < 16)  { kind = 2; dst = B.iq + (slot - 8) * 64; pitch = 512; }
        else if (slot == 16) { kind = 3; dst = B.ik; pitch = 64; }
        else if (slot == 17) { kind = 4; dst = nullptr; pitch = 0; }
        else if (slot < 30)  { kind = 1; dst = B.bq + (slot - 18) * 64; pitch = 768; scale = QSCALE; }
        else if (slot < 42)  { kind = 1; dst = B.bk + (slot - 30) * 64; pitch = 768; }
        else if (slot < 54)  { kind = 0; dst = B.bv + (slot - 42) * 64; pitch = 768; }
        else if (slot < 62)  { kind = 1; dst = B.cq + (slot - 54) * 64; pitch = 512; scale = QSCALE; }
        else if (slot < 64)  { kind = 1; dst = B.ck + (slot - 62) * 64; pitch = 128; }
        else                 { kind = 0; dst = B.cv + (slot - 64) * 64; pitch = 128; }
        float rsv[2][4]; wave_row_rs(ssq, u.pm * BM + wr * 64 + fr, fr, fq, rsv);
#pragma unroll
        for (int ai = 0; ai < 2; ++ai)
#pragma unroll
            for (int m = 0; m < 4; ++m) {
                if ((m & 1) == 0) __builtin_amdgcn_sched_barrier(0);
                const int row = u.pm * BM + ai * HALF + wr * 64 + m * 16 + fr;
                const float rs = rsv[ai][m] * scale;
                f32x4 a0 = acc[ai][0][m][0] * rs, a1 = acc[ai][0][m][1] * rs, b0 = acc[ai][1][m][0] * rs, b1 = acc[ai][1][m][1] * rs;
                if (kind == 4) { if (fq == 0) { float* o = B.iw + (size_t)row * 8; *(f32x4*)o = a0; *(f32x4*)(o + 4) = a1; } continue; }
                if (kind == 3) {
                    float s = (a0.x * a0.x + a0.y * a0.y) + (a0.z * a0.z + a0.w * a0.w) + (a1.x * a1.x + a1.y * a1.y) + (a1.z * a1.z + a1.w * a1.w)
                            + (b0.x * b0.x + b0.y * b0.y) + (b0.z * b0.z + b0.w * b0.w) + (b1.x * b1.x + b1.y * b1.y) + (b1.z * b1.z + b1.w * b1.w);
                    s += __shfl_xor(s, 16); s += __shfl_xor(s, 32);
                    const float r2 = 1.0f / sqrtf(s * (1.0f / 64.f) + NORM_EPS);
                    a0 = a0 * r2 * *(const f32x4*)(iknorm + 8 * fq); a1 = a1 * r2 * *(const f32x4*)(iknorm + 8 * fq + 4); b0 = b0 * r2 * *(const f32x4*)(iknorm + 32 + 8 * fq); b1 = b1 * r2 * *(const f32x4*)(iknorm + 32 + 8 * fq + 4);
                }
                if (kind != 0) {
                    const f32x4* cp = (const f32x4*)(cs + (size_t)row * 32 + 8 * fq);
                    const f32x4 c0 = cp[0], c1 = cp[1], c2 = cp[2], c3 = cp[3];
                    f32x4 na0, na1, nb0, nb1;
                    na0.x = a0.x * c0.x - b0.x * c0.y; nb0.x = b0.x * c0.x + a0.x * c0.y;
                    na0.y = a0.y * c0.z - b0.y * c0.w; nb0.y = b0.y * c0.z + a0.y * c0.w;
                    na0.z = a0.z * c1.x - b0.z * c1.y; nb0.z = b0.z * c1.x + a0.z * c1.y;
                    na0.w = a0.w * c1.z - b0.w * c1.w; nb0.w = b0.w * c1.z + a0.w * c1.w;
                    na1.x = a1.x * c2.x - b1.x * c2.y; nb1.x = b1.x * c2.x + a1.x * c2.y;
                    na1.y = a1.y * c2.z - b1.y * c2.w; nb1.y = b1.y * c2.z + a1.y * c2.w;
                    na1.z = a1.z * c3.x - b1.z * c3.y; nb1.z = b1.z * c3.x + a1.z * c3.y;
                    na1.w = a1.w * c3.z - b1.w * c3.w; nb1.w = b1.w * c3.z + a1.w * c3.w;
                    a0 = na0; a1 = na1; b0 = nb0; b1 = nb1;
                }
                u32x4 wa, wb;
                if (kind >= 2) { wa.x = pkh(a0.x, a0.y); wa.y = pkh(a0.z, a0.w); wa.z = pkh(a1.x, a1.y); wa.w = pkh(a1.z, a1.w); wb.x = pkh(b0.x, b0.y); wb.y = pkh(b0.z, b0.w); wb.z = pkh(b1.x, b1.y); wb.w = pkh(b1.z, b1.w); }
                else           { wa.x = pkbf(a0.x, a0.y); wa.y = pkbf(a0.z, a0.w); wa.z = pkbf(a1.x, a1.y); wa.w = pkbf(a1.z, a1.w); wb.x = pkbf(b0.x, b0.y); wb.y = pkbf(b0.z, b0.w); wb.z = pkbf(b1.x, b1.y); wb.w = pkbf(b1.z, b1.w); }
                bf16_t* o = dst + (size_t)row * pitch + 8 * fq;
                *(u32x4*)o = wa; *(u32x4*)(o + 32) = wb;
            }
    }
};

template <int ACT> struct EpiAct {
    static constexpr bool PERM = true, AFTER_DRAIN = false, KHOOK = false; static constexpr int HOOK_T0 = -1, HOOK_T1 = -1;
    bf16_t* O; int ldc; const float* ssq;
    __device__ __forceinline__ float act(float v) const {
        if (ACT == 0) { const float e = __builtin_amdgcn_exp2f(-1.4426950408889634f * v); const float g = __builtin_amdgcn_rcpf(1.0f + e); return fmaxf(g, 1e-20f); }
        const float r = fmaxf(v, 0.f); return r * r;
    }
    __device__ __forceinline__ void operator()(const f32x4 (&acc)[2][2][4][2], const Unit& u_, int wr, int wc, int fr_, int fq_) const {
        Unit u = u_; int ln_ = (int)(threadIdx.x & 63u); asm volatile("" : "+s"(u.pm), "+s"(u.pn), "+v"(ln_)); const int fr = ln_ & 15, fq = ln_ >> 4;
        const int col0 = u.pn * BM + wc * 32 + 8 * fq;
        float rsv[2][4]; wave_row_rs(ssq, u.pm * BM + wr * 64 + fr, fr, fq, rsv);
#pragma unroll
        for (int ai = 0; ai < 2; ++ai)
#pragma unroll
            for (int m = 0; m < 4; ++m) {
                const int row = u.pm * BM + ai * HALF + wr * 64 + m * 16 + fr;
                const float rs = rsv[ai][m];
                bf16_t* rowp = O + (size_t)row * ldc + col0;
#pragma unroll
                for (int bj = 0; bj < 2; ++bj) {
                    const f32x4 v0 = acc[ai][bj][m][0] * rs, v1 = acc[ai][bj][m][1] * rs;
                    u32x4 w; w.x = pkbf(act(v0.x), act(v0.y)); w.y = pkbf(act(v0.z), act(v0.w)); w.z = pkbf(act(v1.x), act(v1.y)); w.w = pkbf(act(v1.z), act(v1.w));
                    *(u32x4*)(rowp + bj * HALF) = w;
                }
            }
    }
};

struct EpiResid {
    static constexpr bool PERM = true, AFTER_DRAIN = false, KHOOK = false; static constexpr int HOOK_T0 = -1, HOOK_T1 = -1;
    const float* hin; float* hout; bf16_t* hb; float* ssq;
    __device__ __forceinline__ void operator()(const f32x4 (&acc)[2][2][4][2], const Unit& u_, int wr, int wc, int fr_, int fq_) const {
        Unit u = u_; int ln_ = (int)(threadIdx.x & 63u); asm volatile("" : "+s"(u.pm), "+s"(u.pn), "+v"(ln_)); const int fr = ln_ & 15, fq = ln_ >> 4;
        const int col0 = u.pn * BM + wc * 32 + 8 * fq;
#pragma unroll
        for (int ai = 0; ai < 2; ++ai)
#pragma unroll
            for (int m = 0; m < 4; ++m) {
                const int row = u.pm * BM + ai * HALF + wr * 64 + m * 16 + fr;
                float ss = 0.f;
#pragma unroll
                for (int bj = 0; bj < 2; ++bj) {
                    const size_t off = (size_t)row * DMODEL + col0 + bj * HALF;
                    const f32x4 h0 = *(const f32x4*)(hin + off), h1 = *(const f32x4*)(hin + off + 4);
                    const f32x4 v0 = acc[ai][bj][m][0] + h0, v1 = acc[ai][bj][m][1] + h1;
                    *(f32x4*)(hout + off) = v0; *(f32x4*)(hout + off + 4) = v1;
                    u32x4 w; w.x = pkbf(v0.x, v0.y); w.y = pkbf(v0.z, v0.w); w.z = pkbf(v1.x, v1.y); w.w = pkbf(v1.z, v1.w);
                    *(u32x4*)(hb + off) = w;
                    ss += (v0.x * v0.x + v0.y * v0.y) + (v0.z * v0.z + v0.w * v0.w) + (v1.x * v1.x + v1.y * v1.y) + (v1.z * v1.z + v1.w * v1.w);
                }
                ss += __shfl_xor(ss, 16); ss += __shfl_xor(ss, 32);
                if (fq == 0) ssq[(size_t)row * 16 + u.pn * 4 + wc] = ss;
            }
    }
};

struct EpiMerge {
    static constexpr bool PERM = true, AFTER_DRAIN = false, KHOOK = true; static constexpr int HOOK_T0 = 6, HOOK_T1 = 10;
    const bf16_t* gates; bf16_t* merged;
    __device__ __forceinline__ void khook(f32x4 (&acc)[2][2][4][2], const Unit& u_, int t, int wr, int wc, int fr_, int fq_) const {
        Unit u = u_; int ln_ = (int)(threadIdx.x & 63u); asm volatile("" : "+s"(u.pm), "+s"(u.pn), "+v"(ln_)); const int fr = ln_ & 15, fq = ln_ >> 4;
        const int col0 = u.pn * BM + wc * 32 + 8 * fq; const int bi = (t == HOOK_T0) ? 0 : 1;
#pragma unroll
        for (int ch = 0; ch < 4; ++ch) {
            const int ai = ch >> 1, mb = 2 * (ch & 1);
            u32x4 ga[2][2], gb[2][2];
            __builtin_amdgcn_sched_barrier(0);
#pragma unroll
            for (int mm = 0; mm < 2; ++mm)
#pragma unroll
                for (int bj = 0; bj < 2; ++bj) {
                    const int row = u.pm * BM + ai * HALF + wr * 64 + (mb + mm) * 16 + fr;
                    const bf16_t* gp = gates + (size_t)row * 3072 + bi * 1024 + col0 + bj * HALF;
                    ga[mm][bj] = *(const u32x4*)gp; gb[mm][bj] = *(const u32x4*)(gp + 1024);
                }
#pragma unroll
            for (int mm = 0; mm < 2; ++mm)
#pragma unroll
                for (int bj = 0; bj < 2; ++bj) {
                    const int m = mb + mm;
                    const u32x4 a = ga[mm][bj], b = gb[mm][bj];
                    f32x4 r0, r1;
                    r0.x = bflo(a.x) * __builtin_amdgcn_rcpf(bflo(b.x)); r0.y = bfhi(a.x) * __builtin_amdgcn_rcpf(bfhi(b.x));
                    r0.z = bflo(a.y) * __builtin_amdgcn_rcpf(bflo(b.y)); r0.w = bfhi(a.y) * __builtin_amdgcn_rcpf(bfhi(b.y));
                    r1.x = bflo(a.z) * __builtin_amdgcn_rcpf(bflo(b.z)); r1.y = bfhi(a.z) * __builtin_amdgcn_rcpf(bfhi(b.z));
                    r1.z = bflo(a.w) * __builtin_amdgcn_rcpf(bflo(b.w)); r1.w = bfhi(a.w) * __builtin_amdgcn_rcpf(bfhi(b.w));
                    acc[ai][bj][m][0] = acc[ai][bj][m][0] * r0; acc[ai][bj][m][1] = acc[ai][bj][m][1] * r1;
                }
        }
    }
    __device__ __forceinline__ void operator()(const f32x4 (&acc)[2][2][4][2], const Unit& u_, int wr, int wc, int fr_, int fq_) const {
        Unit u = u_; int ln_ = (int)(threadIdx.x & 63u); asm volatile("" : "+s"(u.pm), "+s"(u.pn), "+v"(ln_)); const int fr = ln_ & 15, fq = ln_ >> 4;
        const int col0 = u.pn * BM + wc * 32 + 8 * fq;
#pragma unroll
        for (int ai = 0; ai < 2; ++ai)
#pragma unroll
            for (int m = 0; m < 4; ++m) {
                const int row = u.pm * BM + ai * HALF + wr * 64 + m * 16 + fr;
#pragma unroll
                for (int bj = 0; bj < 2; ++bj) {
                    const u32x4 g = *(const u32x4*)(gates + (size_t)row * 3072 + 2048 + col0 + bj * HALF);
                    const f32x4 a0 = acc[ai][bj][m][0], a1 = acc[ai][bj][m][1];
                    u32x4 w; w.x = pkbf(a0.x * bflo(g.x), a0.y * bfhi(g.x)); w.y = pkbf(a0.z * bflo(g.y), a0.w * bfhi(g.y));
                    w.z = pkbf(a1.x * bflo(g.z), a1.y * bfhi(g.z)); w.w = pkbf(a1.z * bflo(g.w), a1.w * bfhi(g.w));
                    *(u32x4*)(merged + (size_t)row * DMODEL + col0 + bj * HALF) = w;
                }
            }
    }
};
template <class Epi, class Sched, bool ALIGN_EPI = false, bool SP2 = false>
__device__ __forceinline__ void gemm_phase(PG8_LAS unsigned char* lds, const Gemm g, const Sched& S, const Epi& E) {
    int tid_ = threadIdx.x; asm volatile("" : "+v"(tid_));
    const int tid = tid_, wid = __builtin_amdgcn_readfirstlane(tid >> 6), lane = tid & 63, wr = wid >> 2, wc = wid & 3, fr = lane & 15, fq = lane >> 4;
    const int K = g.K, nt = K / BK;
    unsigned voffA[2], voffB[2];
#pragma unroll
    for (int i = 0; i < 2; ++i) { int R, C; stage_rc(tid * 16 + i * 8192, R, C); const int Rb = Epi::PERM ? ((R & ~31) + perm32(R & 31)) : R;
        voffA[i] = (unsigned)(R * K + C) * 2u; voffB[i] = (unsigned)(Rb * K + C) * 2u; }
    const size_t kstep = (size_t)(BK * 2);
    const size_t hstep = (size_t)HALF * K * 2;
    const size_t tstep = 2 * hstep;
    const unsigned ldsw = (unsigned)wid * 1024u;
    const int aoff = lds_byte(wr * 64 + fr, fq * 8), boff = lds_byte(wc * 32 + fr, fq * 8);
#define PG8_SA(b, h) (((b) * 2 + (h)) * HTB)
#define PG8_SB(b, h) ((4 + (b) * 2 + (h)) * HTB)
#define PG8_STAGE(bufoff, gbase, voff) do { _Pragma("unroll") for (int _i = 0; _i < 2; ++_i) \
        __builtin_amdgcn_global_load_lds((const unsigned*)((const char*)(gbase) + (voff)[_i]), (PG8_LAS unsigned*)(lds + (bufoff) + ldsw + _i * 8192), 16, 0, 0); } while (0)
#define PG8_LDA(dst, b, h) do { _Pragma("unroll") for (int m = 0; m < 4; ++m) _Pragma("unroll") for (int k = 0; k < 2; ++k) dst[m][k] = *(const PG8_LAS bf16x8*)(lds + PG8_SA(b, h) + aoff + m * 2048 + k * 1024); } while (0)
#define PG8_LDB(dst, b, h) do { _Pragma("unroll") for (int n = 0; n < 2; ++n) _Pragma("unroll") for (int k = 0; k < 2; ++k) dst[n][k] = *(const PG8_LAS bf16x8*)(lds + PG8_SB(b, h) + boff + n * 2048 + k * 1024); } while (0)
#define PG8_MMA(ai, bj, At, Bt) do { __builtin_amdgcn_s_setprio(1); _Pragma("unroll") for (int m = 0; m < 4; ++m) _Pragma("unroll") for (int n = 0; n < 2; ++n) _Pragma("unroll") for (int k = 0; k < 2; ++k) \
        acc[ai][bj][m][n] = __builtin_amdgcn_mfma_f32_16x16x32_bf16(Bt[n][k], At[m][k], acc[ai][bj][m][n], 0, 0, 0); __builtin_amdgcn_s_setprio(0); } while (0)
#define PG8_WAIT_V(n) asm volatile("s_waitcnt vmcnt(" #n ")" ::: "memory")
#define PG8_WAIT_L(n) asm volatile("s_waitcnt lgkmcnt(" #n ")" ::: "memory")
#define PG8_BAR __builtin_amdgcn_s_barrier()
#define PG8_SCHED __builtin_amdgcn_sched_barrier(0)
    Unit cur, nxt; int ui = 0;
    if (!S.next(0, cur)) return;
    f32x4 acc[2][2][4][2];
#pragma unroll
    for (int a = 0; a < 2; ++a)
#pragma unroll
        for (int b = 0; b < 2; ++b)
#pragma unroll
            for (int m = 0; m < 4; ++m)
#pragma unroll
                for (int n = 0; n < 2; ++n) acc[a][b][m][n] = (f32x4){0.f, 0.f, 0.f, 0.f};
    bf16x8 At[4][2], B0[2][2], B1[2][2];
    const char* cA = (const char*)g.A + (size_t)cur.pm * tstep; const char* cB = (const char*)g.Bt + (size_t)cur.pn * tstep;
    S.a_ready(cur);
    if constexpr (SP2) {
        PG8_STAGE(PG8_SB(0, 0), cB, voffB); PG8_STAGE(PG8_SB(0, 1), cB + hstep, voffB); PG8_STAGE(PG8_SA(0, 0), cA, voffA); PG8_STAGE(PG8_SA(0, 1), cA + hstep, voffA);
        if (wr == 1) PG8_BAR;
        PG8_WAIT_V(2); PG8_BAR;
        PG8_STAGE(PG8_SB(1, 0), cB + kstep, voffB); PG8_STAGE(PG8_SA(1, 0), cA + kstep, voffA); PG8_STAGE(PG8_SB(1, 1), cB + hstep + kstep, voffB);
        PG8_WAIT_V(6); PG8_BAR;
    } else {
        PG8_STAGE(PG8_SB(0, 0), cB, voffB); PG8_STAGE(PG8_SA(0, 0), cA, voffA); PG8_STAGE(PG8_SB(0, 1), cB + hstep, voffB); PG8_STAGE(PG8_SA(0, 1), cA + hstep, voffA);
        if (wr == 1) PG8_BAR;
        PG8_WAIT_V(4); PG8_BAR;
        PG8_STAGE(PG8_SB(1, 0), cB + kstep, voffB); PG8_STAGE(PG8_SA(1, 0), cA + kstep, voffA); PG8_STAGE(PG8_SB(1, 1), cB + hstep + kstep, voffB);
        PG8_WAIT_V(6); PG8_BAR;
    }
    for (;;) {
        const bool has_next = S.next(ui + 1, nxt);
        const char* nA = has_next ? (const char*)g.A + (size_t)nxt.pm * tstep : cA; const char* nB = has_next ? (const char*)g.Bt + (size_t)nxt.pn * tstep : cB;
        for (int t = 0; t < nt; t += 2) {
            if constexpr (Epi::KHOOK) { if (t == Epi::HOOK_T0 || t == Epi::HOOK_T1) E.khook(acc, cur, t, wr, wc, fr, fq); }
            const bool last = (t == nt - 2);
            const char* a1 = cA + (size_t)(t + 1) * kstep;
            const char* a2 = last ? nA : cA + (size_t)(t + 2) * kstep; const char* b2 = last ? nB : cB + (size_t)(t + 2) * kstep;
            const char* a3 = a2 + kstep; const char* b3 = b2 + kstep;
            if (last && has_next) S.a_ready(nxt);
            if constexpr (SP2) {
            PG8_LDB(B0, 0, 0); PG8_LDB(B1, 0, 1); PG8_SCHED; PG8_LDA(At, 0, 0); PG8_STAGE(PG8_SA(1, 1), a1 + hstep, voffA);
            PG8_WAIT_V(8); PG8_WAIT_L(0); PG8_BAR; PG8_MMA(0, 0, At, B0); PG8_MMA(0, 1, At, B1); PG8_BAR; PG8_SCHED;
            PG8_LDA(At, 0, 1); PG8_STAGE(PG8_SB(0, 0), b2, voffB); PG8_STAGE(PG8_SB(0, 1), b2 + hstep, voffB); PG8_STAGE(PG8_SA(0, 0), a2, voffA);
            PG8_WAIT_V(8); PG8_WAIT_L(0); PG8_BAR; PG8_MMA(1, 0, At, B0); PG8_MMA(1, 1, At, B1); PG8_BAR; PG8_SCHED;
            PG8_LDB(B0, 1, 0); PG8_LDB(B1, 1, 1); PG8_SCHED; PG8_LDA(At, 1, 0); PG8_STAGE(PG8_SA(0, 1), a2 + hstep, voffA);
            PG8_WAIT_V(8); PG8_WAIT_L(0); PG8_BAR; PG8_MMA(0, 0, At, B0); PG8_MMA(0, 1, At, B1); PG8_BAR; PG8_SCHED;
            PG8_LDA(At, 1, 1); PG8_STAGE(PG8_SB(1, 0), b3, voffB); PG8_STAGE(PG8_SB(1, 1), b3 + hstep, voffB); PG8_STAGE(PG8_SA(1, 0), a3, voffA);
            PG8_WAIT_V(8); PG8_WAIT_L(0); PG8_BAR; PG8_MMA(1, 0, At, B0); PG8_MMA(1, 1, At, B1); PG8_BAR; PG8_SCHED;
            } else {
            PG8_LDB(B0, 0, 0); PG8_SCHED; PG8_LDA(At, 0, 0); PG8_STAGE(PG8_SA(1, 1), a1 + hstep, voffA);
            PG8_WAIT_L(8); PG8_BAR; PG8_WAIT_L(0); PG8_MMA(0, 0, At, B0); PG8_BAR; PG8_SCHED;
            PG8_LDB(B1, 0, 1); PG8_STAGE(PG8_SB(0, 0), b2, voffB);
            PG8_BAR; PG8_WAIT_L(0); PG8_MMA(0, 1, At, B1); PG8_BAR;
            PG8_LDA(At, 0, 1); PG8_STAGE(PG8_SA(0, 0), a2, voffA);
            PG8_BAR; PG8_WAIT_L(0); PG8_MMA(1, 0, At, B0); PG8_BAR; PG8_SCHED;
            PG8_STAGE(PG8_SB(0, 1), b2 + hstep, voffB);
            PG8_WAIT_V(6); PG8_BAR; PG8_MMA(1, 1, At, B1); PG8_BAR;
            PG8_LDB(B0, 1, 0); PG8_SCHED; PG8_LDA(At, 1, 0); PG8_STAGE(PG8_SA(0, 1), a2 + hstep, voffA);
            PG8_WAIT_L(8); PG8_BAR; PG8_WAIT_L(0); PG8_MMA(0, 0, At, B0); PG8_BAR; PG8_SCHED;
            PG8_LDB(B1, 1, 1); PG8_STAGE(PG8_SB(1, 0), b3, voffB);
            PG8_BAR; PG8_WAIT_L(0); PG8_MMA(0, 1, At, B1); PG8_BAR;
            PG8_LDA(At, 1, 1); PG8_STAGE(PG8_SA(1, 0), a3, voffA);
            PG8_BAR; PG8_WAIT_L(0); PG8_MMA(1, 0, At, B0); PG8_BAR; PG8_SCHED;
            PG8_STAGE(PG8_SB(1, 1), b3 + hstep, voffB);
            PG8_WAIT_V(6); PG8_BAR; PG8_MMA(1, 1, At, B1); PG8_BAR;
            }
        }
        if constexpr (ALIGN_EPI) { if (wr == 0) PG8_BAR; }
        if constexpr (!Epi::AFTER_DRAIN) { E(acc, cur, wr, wc, fr, fq); S.done(cur); }
        if (!has_next) break;
#pragma unroll
        for (int a = 0; a < 2; ++a)
#pragma unroll
            for (int b = 0; b < 2; ++b)
#pragma unroll
                for (int m = 0; m < 4; ++m)
#pragma unroll
                    for (int n = 0; n < 2; ++n) acc[a][b][m][n] = (f32x4){0.f, 0.f, 0.f, 0.f};
        cur = nxt; cA = nA; cB = nB; ++ui;
        if constexpr (ALIGN_EPI) { if (wr == 1) PG8_BAR; }
    }
    PG8_WAIT_V(0);
    if constexpr (!ALIGN_EPI) { if (wr == 0) PG8_BAR; }
    PG8_BAR;
    if constexpr (Epi::AFTER_DRAIN) { E.fused(acc, cur, wr, wc, fr, fq, lds, wid, lane); S.done(cur); }
#undef PG8_SA
#undef PG8_SB
#undef PG8_STAGE
#undef PG8_LDA
#undef PG8_LDB
#undef PG8_MMA
#undef PG8_WAIT_V
#undef PG8_WAIT_L
#undef PG8_BAR
#undef PG8_SCHED
}
}
#define GAS __attribute__((address_space(1)))
#define LAS __attribute__((address_space(3)))
typedef unsigned short bf16;
typedef unsigned v4u __attribute__((ext_vector_type(4)));
typedef float f32x4 __attribute__((ext_vector_type(4)));
typedef short bf16x8 __attribute__((ext_vector_type(8)));
typedef GAS unsigned gu32;
typedef GAS unsigned long long gu64;
#define RLX_AGENT __ATOMIC_RELAXED, __HIP_MEMORY_SCOPE_AGENT
#define LDS_WAIT() asm volatile("s_waitcnt lgkmcnt(0)" ::: "memory")
#define VM_WAIT() asm volatile("s_waitcnt vmcnt(0)" ::: "memory")
__device__ __forceinline__ unsigned long long rt() { return __builtin_amdgcn_s_memrealtime(); }
__device__ __forceinline__ unsigned f2bf(float f) { unsigned u = __builtin_bit_cast(unsigned, f); return (u + 0x7fffu + ((u >> 16) & 1u)) >> 16; }
__device__ __forceinline__ unsigned pk2(float lo, float hi) { return f2bf(lo) | (f2bf(hi) << 16); }

#define XB_TMO      128
#define XB_XCNT(j)  (256  + 64 * (j))
#define XB_XSUB(j)  (1280 + 64 * (j))
#define XB_XGEN(j)  (2304 + 64 * (j))
#define XB_TOP      3328
#define XB_TOPGEN   3392
#define XCD_BAR_WORDS 3456
#define XB_SPIN_CAP (1u << 18)

__device__ __forceinline__ unsigned xb_ld(unsigned* p)              { return __hip_atomic_load(p, __ATOMIC_RELAXED, __HIP_MEMORY_SCOPE_AGENT); }
__device__ __forceinline__ unsigned xb_add(unsigned* p, unsigned v) { return __hip_atomic_fetch_add(p, v, __ATOMIC_RELAXED, __HIP_MEMORY_SCOPE_AGENT); }
__device__ __forceinline__ unsigned xb_xcc_id() { return (unsigned)__builtin_amdgcn_s_getreg((3 << 11) | 20) & 0xFu; }
#define XB_SPIN(cond, bar) do { unsigned _sp = 0; while (cond) { __builtin_amdgcn_s_sleep(1); \
    if ((++_sp & 255u) == 0u) { if (xb_ld(&(bar)[XB_TMO])) break; if (_sp > XB_SPIN_CAP) { atomicAdd(&(bar)[XB_TMO], 1u); break; } } } } while (0)

struct XcdBarrier {
    unsigned* bar; unsigned x;
    volatile LAS unsigned* st;
};

__device__ __forceinline__ XcdBarrier xcd_barrier_post(unsigned* bar, volatile LAS unsigned* st) {
    XcdBarrier b; b.bar = bar; b.x = xb_xcc_id(); b.st = st;
    if (threadIdx.x == 0) (void)xb_add(&bar[XB_XCNT(b.x)], 1u);
    return b;
}
__device__ __forceinline__ void xcd_barrier_complete(unsigned* bar, unsigned x, unsigned& nloc, unsigned& nx) {
    const unsigned G = gridDim.x * gridDim.y * gridDim.z;
    unsigned sum, cnt, mine, sp = 0u;
    for (;;) {
        sum = 0u; cnt = 0u; mine = 0u;
#pragma unroll
        for (unsigned j = 0; j < 16; ++j) { const unsigned c = xb_ld(&bar[XB_XCNT(j)]); sum += c; cnt += (c > 0u) ? 1u : 0u; mine = (j == x) ? c : mine; }
        if (sum == G) break;
        __builtin_amdgcn_s_sleep(1);
        if ((++sp & 255u) == 0u) { if (xb_ld(&bar[XB_TMO])) break; if (sp > XB_SPIN_CAP) { atomicAdd(&bar[XB_TMO], 1u); break; } }
    }
    nloc = mine > 0u ? mine : 1u; nx = cnt > 0u ? cnt : 1u;
}

__device__ __forceinline__ void xcd_barrier(const XcdBarrier& b) {
    asm volatile("s_waitcnt vmcnt(0)" ::: "memory");
    __syncthreads();
    if (threadIdx.x == 0) {
        unsigned* bar = b.bar;
        __builtin_amdgcn_s_waitcnt(0);
        unsigned nloc = b.st[0], nx = b.st[1];
        if (nloc == 0u) { xcd_barrier_complete(bar, b.x, nloc, nx); b.st[0] = nloc; b.st[1] = nx; }
        const unsigned old = xb_add(&bar[XB_XSUB(b.x)], 1u);
        const unsigned gen = old / nloc;
        if (old + 1u == (gen + 1u) * nloc) {
            __builtin_amdgcn_fence(__ATOMIC_RELEASE, "agent");
            asm volatile("s_waitcnt vmcnt(0)" ::: "memory");
            const unsigned og = xb_add(&bar[XB_TOP], 1u);
            const unsigned tg = og / nx;
            if (og + 1u == (tg + 1u) * nx) xb_add(&bar[XB_TOPGEN], 1u);
            else XB_SPIN(xb_ld(&bar[XB_TOPGEN]) == tg, bar);
            __builtin_amdgcn_fence(__ATOMIC_ACQUIRE, "agent");
            xb_add(&bar[XB_XGEN(b.x)], 1u);
            asm volatile("s_waitcnt vmcnt(0)" ::: "memory");
        } else {
            XB_SPIN(xb_ld(&bar[XB_XGEN(b.x)]) == gen, bar);
            __builtin_amdgcn_fence(__ATOMIC_ACQUIRE, "agent");
            asm volatile("s_waitcnt vmcnt(0)" ::: "memory");
        }
    }
    __syncthreads();
}

constexpr int NB = 8, SEQ = 4096, TOK = NB * SEQ, DM = 1024, FF = 4096, DEPTH = 2;
constexpr int IN_W = 7240;
constexpr int NQKV = 4352;
constexpr int NGATE = 3072, KMERGE = 1152;
constexpr int NWAVES = 8;
#ifndef MK_ONE_LAUNCH
#define MK_ONE_LAUNCH 0
#endif
constexpr int N_PHASES = 19;

constexpr size_t MiB = 1u << 20;
constexpr size_t WS_CTL = 0, CTL_ZERO_BYTES = 1 * MiB;
constexpr size_t WS_WQKV = 1 * MiB;
constexpr size_t WS_WG   = WS_WQKV + (size_t)NQKV * DM * 2;
constexpr size_t WS_WM   = WS_WG + (size_t)NGATE * DM * 2;
constexpr size_t WS_WO   = WS_WM + (size_t)DM * KMERGE * 2;
constexpr size_t WS_WUP  = WS_WO + (size_t)DM * DM * 2;
constexpr size_t WS_WDN  = WS_WUP + (size_t)FF * DM * 2;
constexpr size_t WS_HB   = 36 * MiB;
constexpr size_t WS_SSQ  = 100 * MiB;
constexpr size_t WS_CS   = 102 * MiB;
constexpr size_t WS_O    = 110 * MiB;
constexpr size_t WS_OG   = 182 * MiB;
constexpr size_t WS_LSE  = 230 * MiB;
constexpr size_t WS_ZA   = 232 * MiB;
constexpr size_t WS_AQ = WS_ZA, WS_AK = WS_AQ + 24 * MiB, WS_AV = WS_AK + 4 * MiB, WS_IQ = WS_AV + 4 * MiB, WS_IK = WS_IQ + 32 * MiB, WS_IW = WS_IK + 4 * MiB;
constexpr size_t WS_ZBC  = 302 * MiB;
constexpr size_t WS_BQ = WS_ZBC, WS_BK = WS_BQ + 48 * MiB, WS_BV = WS_BK + 48 * MiB, WS_CQ = WS_BV + 48 * MiB, WS_CK = WS_CQ + 32 * MiB, WS_CV = WS_CK + 8 * MiB;
constexpr size_t WS_END  = 494 * MiB;
constexpr size_t WS_SLAB = WS_ZBC;
constexpr size_t WS_GATES = WS_ZBC;
constexpr size_t WS_MERGED = WS_ZA;
constexpr size_t WS_HID = WS_ZA;
static_assert(WS_WDN + (size_t)DM * FF * 2 <= WS_HB && WS_IW + (size_t)TOK * 8 * 4 <= WS_ZBC && WS_CV + 8 * MiB == WS_END && WS_HID + (size_t)TOK * FF * 2 <= WS_END, "d_ws map");
constexpr int CW_BAR = 4096;

constexpr int RING_BYTES = 131072;
constexpr int LDSCTL_OFF = RING_BYTES, MISC_OFF = LDSCTL_OFF + 320;
constexpr int LDS_BYTES = 147456;

typedef float f32x16 __attribute__((ext_vector_type(16)));
typedef float f32x2 __attribute__((ext_vector_type(2)));
typedef _Float16 f16x8 __attribute__((ext_vector_type(8)));
typedef short s16x4 __attribute__((ext_vector_type(4)));
typedef short v4i16_t __attribute__((ext_vector_type(4)));
typedef unsigned u32x2 __attribute__((ext_vector_type(2)));
#define DI __device__ __forceinline__
using pg8::pkbf; using pg8::bflo; using pg8::bfhi; using pg8::u32x4; using pg8::bf16_t;

DI int crow(int i, int h) { return (i & 3) + 8 * (i >> 2) + 4 * h; }
DI float wave_sum(float v) {
#pragma unroll
    for (int o = 1; o < 64; o <<= 1) v += __shfl_xor(v, o);
    return v;
}
DI s16x4 vtr(const LAS char* p) { return __builtin_bit_cast(s16x4, __builtin_amdgcn_ds_read_tr16_b64_v4i16((LAS v4i16_t*)p)); }

struct OState { f32x16 o0, o1; float m, l; };

DI void stage_v(LAS char* vbuf, const char* vrow, int lane) {
    const int r = lane & 31, h = lane >> 5;
    const u32x4* src = (const u32x4*)(vrow + 64 * h);
    const u32x4 a = src[0], b = src[1], c = src[2], d = src[3];
    LAS u32x4* dst = (LAS u32x4*)(vbuf + r * 128 + 64 * h);
    dst[0] = a; dst[1] = b; dst[2] = c; dst[3] = d;
}

DI void softmax_pv(OState& S, f32x16 s, const LAS char* vbuf, int lane) {
    float mx = s[0];
#pragma unroll
    for (int i = 1; i < 16; ++i) mx = fmaxf(mx, s[i]);
    mx = fmaxf(mx, __shfl_xor(mx, 32));
    const float mnew = fmaxf(S.m, mx);
    const float msafe = (mnew == -INFINITY) ? 0.f : mnew;
    const float alpha = __builtin_amdgcn_exp2f(S.m - msafe);
    float p[16]; float ls = 0.f;
#pragma unroll
    for (int i = 0; i < 16; ++i) { p[i] = __builtin_amdgcn_exp2f(s[i] - msafe); ls += p[i]; }
    ls += __shfl_xor(ls, 32);
    S.l = S.l * alpha + ls; S.m = mnew;
    S.o0 = S.o0 * alpha; S.o1 = S.o1 * alpha;
    u32x4 w0, w1;
    w0.x = pkbf(p[0], p[1]); w0.y = pkbf(p[2], p[3]); w0.z = pkbf(p[4], p[5]); w0.w = pkbf(p[6], p[7]);
    w1.x = pkbf(p[8], p[9]); w1.y = pkbf(p[10], p[11]); w1.z = pkbf(p[12], p[13]); w1.w = pkbf(p[14], p[15]);
    const bf16x8 pb0 = __builtin_bit_cast(bf16x8, w0), pb1 = __builtin_bit_cast(bf16x8, w1);
    const int h = lane >> 5, i16 = lane & 15, q = i16 >> 2, pp = i16 & 3, g16 = (lane >> 4) & 1;
    const LAS char* vb = vbuf + (4 * h + q) * 128 + (16 * g16 + 4 * pp) * 2;
#pragma unroll
    for (int dt = 0; dt < 2; ++dt) {
        const s16x4 lo0 = vtr(vb + dt * 64), hi0 = vtr(vb + dt * 64 + 8 * 128), lo1 = vtr(vb + dt * 64 + 16 * 128), hi1 = vtr(vb + dt * 64 + 24 * 128);
        const bf16x8 va0 = __builtin_shufflevector(lo0, hi0, 0, 1, 2, 3, 4, 5, 6, 7), va1 = __builtin_shufflevector(lo1, hi1, 0, 1, 2, 3, 4, 5, 6, 7);
        if (dt == 0) { S.o0 = __builtin_amdgcn_mfma_f32_32x32x16_bf16(va0, pb0, S.o0, 0, 0, 0); S.o0 = __builtin_amdgcn_mfma_f32_32x32x16_bf16(va1, pb1, S.o0, 0, 0, 0); }
        else         { S.o1 = __builtin_amdgcn_mfma_f32_32x32x16_bf16(va0, pb0, S.o1, 0, 0, 0); S.o1 = __builtin_amdgcn_mfma_f32_32x32x16_bf16(va1, pb1, S.o1, 0, 0, 0); }
    }
}

DI f32x16 zero16() { f32x16 z;
#pragma unroll
    for (int i = 0; i < 16; ++i) z[i] = 0.f;
    return z; }

DI f32x16 qk_tile(const bf16x8 (&qf)[4], const char* krow, int h) {
    bf16x8 kf[4];
#pragma unroll
    for (int s = 0; s < 4; ++s) kf[s] = *(const bf16x8*)(krow + 32 * s + 16 * h);
    f32x16 st = zero16();
#pragma unroll
    for (int s = 0; s < 4; ++s) st = __builtin_amdgcn_mfma_f32_32x32x16_bf16(kf[s], qf[s], st, 0, 0, 0);
    return st;
}

DI void store_ot(const OState& S, bf16_t* orow, int h) {
    const float inv = 1.0f / S.l;
#pragma unroll
    for (int g = 0; g < 4; ++g) {
        u32x2 w0, w1;
        w0.x = pkbf(S.o0[4 * g] * inv, S.o0[4 * g + 1] * inv); w0.y = pkbf(S.o0[4 * g + 2] * inv, S.o0[4 * g + 3] * inv);
        w1.x = pkbf(S.o1[4 * g] * inv, S.o1[4 * g + 1] * inv); w1.y = pkbf(S.o1[4 * g + 2] * inv, S.o1[4 * g + 3] * inv);
        *(u32x2*)(orow + 8 * g + 4 * h) = w0; *(u32x2*)(orow + 32 + 8 * g + 4 * h) = w1;
    }
}

DI void window_task(OState& S, const bf16_t* Q, int pq, const bf16_t* K, const bf16_t* V, int pkv, int tb, int d, int r0, int i0, int W, LAS char* vbuf2, int lane) {
    const int r = lane & 31, h = lane >> 5;
    const int tq = tb + r0 + d * (i0 + r);
    bf16x8 qf[4];
#pragma unroll
    for (int s = 0; s < 4; ++s) qf[s] = *(const bf16x8*)(Q + (size_t)tq * pq + 16 * s + 8 * h);
    const int qi = i0 + r;
#pragma unroll 1
    for (int kt = 0; kt < 5; ++kt) {
        const int kc0 = i0 - 128 + 32 * kt;
        if (kc0 + 31 < 0) continue;
        int kcl = kc0 + r; kcl = kcl < 0 ? 0 : kcl;
        const size_t tk = (size_t)(tb + r0 + d * kcl) * pkv;
        LAS char* vbuf = vbuf2 + (kt & 1) * 4096;
        stage_v(vbuf, (const char*)(V + tk), lane);
        f32x16 st = qk_tile(qf, (const char*)(K + tk), h);
#pragma unroll
        for (int i = 0; i < 16; ++i) { const int kci = kc0 + crow(i, h); const bool ok = (kci >= 0) && (kci <= qi) && (kci > qi - W); st[i] = ok ? st[i] : -INFINITY; }
        softmax_pv(S, st, vbuf, lane);
    }
}

struct Ptrs {
    const float* x; const int* pos; const float *attn_norm, *w_in, *iknorm, *sinks, *w_a, *w_b, *w_c, *w_o, *mlp_norm, *w_up, *w_down, *final_norm;
    float* out; unsigned char* ws;
};

DI void attn_bc_task(const Ptrs& P, int layer, int b, int tb_, LAS char* vbuf2, int lane) {
    const int r = lane & 31, h = lane >> 5, tb = b * SEQ;
    OState S; S.o0 = zero16(); S.o1 = zero16();
    if (tb_ < 1536) {
        const int tile_in = tb_ & 127, j = (tb_ >> 7) & 3, g = tb_ >> 9;
        const int d = (g == 0) ? 1 : (g == 1 ? 4 : 16);
        const int r0 = tile_in % d, i0 = 32 * (tile_in / d), head = 4 * g + j;
        const bf16_t* Q = (const bf16_t*)(P.ws + WS_BQ) + head * 64; const bf16_t* K = (const bf16_t*)(P.ws + WS_BK) + head * 64; const bf16_t* V = (const bf16_t*)(P.ws + WS_BV) + head * 64;
        S.m = -INFINITY; S.l = 0.f;
        window_task(S, Q, 768, K, V, 768, tb, d, r0, i0, 129, vbuf2, lane);
        const int tq = tb + r0 + d * (i0 + r);
        bf16_t* og = (bf16_t*)(P.ws + WS_OG) + ((size_t)g * TOK + tq) * 256 + j * 64;
        store_ot(S, og, h);
        if (h == 0) ((float*)(P.ws + WS_LSE))[((size_t)g * TOK + tq) * 4 + j] = S.m + __builtin_amdgcn_logf(S.l);
    } else {
        const int c = tb_ - 1536, tile = c & 127, head = c >> 7, kvh = head >> 2;
        const bf16_t* Q = (const bf16_t*)(P.ws + WS_CQ) + head * 64; const bf16_t* K = (const bf16_t*)(P.ws + WS_CK) + kvh * 64; const bf16_t* V = (const bf16_t*)(P.ws + WS_CV) + kvh * 64;
        S.m = P.sinks[layer * 8 + head] * 1.4426950408889634f; S.l = 1.f;
        window_task(S, Q, 512, K, V, 128, tb, 1, 0, 32 * tile, 128, vbuf2, lane);
        const int tq = tb + 32 * tile + r;
        store_ot(S, (bf16_t*)(P.ws + WS_O) + (size_t)tq * KMERGE + 640 + head * 64, h);
    }
}

DI void attn_bc_phase(const Ptrs& P, int layer, LAS unsigned char* lds, int wave, int lane) {
    LAS char* vbuf2 = (LAS char*)lds + wave * 8192;
    const int G = gridDim.x, w = blockIdx.x;
    if ((G & 7) == 0) {
        const int b = w & 7, nwb = G >> 3;
        for (int t = (w >> 3) * NWAVES + wave; t < 2560; t += nwb * NWAVES) attn_bc_task(P, layer, b, t, vbuf2, lane);
    } else {
        for (int id = w * NWAVES + wave; id < 8 * 2560; id += G * NWAVES) attn_bc_task(P, layer, id / 2560, id % 2560, vbuf2, lane);
    }
}

DI void bmerge_rows(const Ptrs& P, int wave, int lane) {
    const int G = gridDim.x;
    const bf16_t* og = (const bf16_t*)(P.ws + WS_OG); const float* lse = (const float*)(P.ws + WS_LSE); bf16_t* O = (bf16_t*)(P.ws + WS_O);
    const int j = lane >> 4, e = 4 * (lane & 15);
    for (int t = blockIdx.x * NWAVES + wave; t < TOK; t += G * NWAVES) {
        const float l0 = lse[(size_t)t * 4 + j], l1 = lse[((size_t)TOK + t) * 4 + j], l2 = lse[((size_t)2 * TOK + t) * 4 + j];
        const float mx = fmaxf(l0, fmaxf(l1, l2));
        float a0 = __builtin_amdgcn_exp2f(l0 - mx), a1 = __builtin_amdgcn_exp2f(l1 - mx), a2 = __builtin_amdgcn_exp2f(l2 - mx);
        const float inv = 1.0f / (a0 + a1 + a2); a0 *= inv; a1 *= inv; a2 *= inv;
        const u32x2 v0 = *(const u32x2*)(og + (size_t)t * 256 + j * 64 + e), v1 = *(const u32x2*)(og + ((size_t)TOK + t) * 256 + j * 64 + e), v2 = *(const u32x2*)(og + ((size_t)2 * TOK + t) * 256 + j * 64 + e);
        u32x2 o;
        o.x = pkbf(a0 * bflo(v0.x) + a1 * bflo(v1.x) + a2 * bflo(v2.x), a0 * bfhi(v0.x) + a1 * bfhi(v1.x) + a2 * bfhi(v2.x));
        o.y = pkbf(a0 * bflo(v0.y) + a1 * bflo(v1.y) + a2 * bflo(v2.y), a0 * bfhi(v0.y) + a1 * bfhi(v1.y) + a2 * bfhi(v2.y));
        *(u32x2*)(O + (size_t)t * KMERGE + 384 + j * 64 + e) = o;
    }
}

DI unsigned mono_key(float f) { const unsigned u = __builtin_bit_cast(unsigned, f); return u ^ ((unsigned)((int)u >> 31) | 0x80000000u); }
DI unsigned lane_lt_count(unsigned long long m) { return __builtin_amdgcn_mbcnt_hi((unsigned)(m >> 32), __builtin_amdgcn_mbcnt_lo((unsigned)m, 0u)); }

template <int LOGB> DI void hist_find(const LAS unsigned* hist, unsigned need, int lane, unsigned& B, unsigned& above, unsigned& cB) {
    constexpr int PER = (1 << LOGB) / 64;
    unsigned s = 0;
#pragma unroll
    for (int b = 0; b < PER; ++b) s += hist[lane * PER + ((b + lane) & (PER - 1))];
    unsigned suf = s;
#pragma unroll
    for (int off = 1; off < 64; off <<= 1) { const unsigned v = __shfl_down(suf, off); if (lane + off < 64) suf += v; }
    const unsigned long long mk = __ballot(suf >= need);
    const int Lc = 63 - __builtin_clzll(mk | 1ull);
    const unsigned run0 = __shfl(suf, Lc) - __shfl(s, Lc);
    const unsigned cb = (lane < PER) ? hist[Lc * PER + lane] : 0u;
    unsigned suf2 = cb;
#pragma unroll
    for (int off = 1; off < 64; off <<= 1) { const unsigned v = __shfl_down(suf2, off); if (lane + off < 64) suf2 += v; }
    const unsigned long long mk2 = __ballot((lane < PER) && (run0 + suf2 >= need));
    const int bc = 63 - __builtin_clzll(mk2 | 1ull);
    B = (unsigned)(Lc * PER + bc); cB = __shfl(cb, bc); above = run0 + __shfl(suf2, bc) - cB;
}
template <int LOGB> DI void hist_zero(LAS unsigned* hist, int lane) {
    constexpr int N4 = (1 << LOGB) / 4 / 64;
#pragma unroll
    for (int i = 0; i < N4; ++i) ((LAS u32x4*)hist)[i * 64 + lane] = (u32x4){0u, 0u, 0u, 0u};
}

DI void select_top256(const float* row, int n, LAS unsigned* hist, LAS unsigned short* idx, int lane) {
    unsigned B1, ab1, c1;
    hist_zero<11>(hist, lane);
#pragma unroll 4
    for (int base = 0; base < n; base += 64) { const int e = base + lane; if (e < n) { const unsigned k = mono_key(row[e]); __hip_atomic_fetch_add(hist + (k >> 21), 1u, __ATOMIC_RELAXED, __HIP_MEMORY_SCOPE_WAVEFRONT); } }
    hist_find<11>(hist, 256u, lane, B1, ab1, c1);
    unsigned need = 256u - ab1;
    unsigned kgt, kstar = 0u, quota = 0u;
    if (c1 == need) { kgt = (B1 << 21) - 1u; }
    else {
        unsigned B2, ab2, c2;
        hist_zero<11>(hist, lane);
#pragma unroll 4
        for (int base = 0; base < n; base += 64) { const int e = base + lane; if (e < n) { const unsigned k = mono_key(row[e]); if ((k >> 21) == B1) __hip_atomic_fetch_add(hist + ((k >> 10) & 0x7ffu), 1u, __ATOMIC_RELAXED, __HIP_MEMORY_SCOPE_WAVEFRONT); } }
        hist_find<11>(hist, need, lane, B2, ab2, c2);
        need -= ab2;
        const unsigned pre = (B1 << 11) | B2;
        if (c2 == need) { kgt = (pre << 10) - 1u; }
        else {
            unsigned B3, ab3, c3;
            hist_zero<10>(hist, lane);
#pragma unroll 4
            for (int base = 0; base < n; base += 64) { const int e = base + lane; if (e < n) { const unsigned k = mono_key(row[e]); if ((k >> 10) == pre) __hip_atomic_fetch_add(hist + (k & 0x3ffu), 1u, __ATOMIC_RELAXED, __HIP_MEMORY_SCOPE_WAVEFRONT); } }
            hist_find<10>(hist, need, lane, B3, ab3, c3);
            need -= ab3;
            kstar = (pre << 10) | B3; kgt = kstar; quota = need;
        }
    }
    unsigned outn = 0, eqn = 0;
#pragma unroll 2
    for (int base = 0; base < n; base += 64) {
        const int e = base + lane; const bool v = e < n;
        const unsigned k = v ? mono_key(row[e]) : 0u;
        const bool eq = v && (quota != 0u) && (k == kstar);
        const unsigned long long em = __ballot(eq);
        const bool sel = v && ((k > kgt) || (eq && (eqn + lane_lt_count(em) < quota)));
        const unsigned long long sm = __ballot(sel);
        const unsigned pos = outn + lane_lt_count(sm);
        if (sel && pos < 256u) idx[pos] = (unsigned short)e;
        outn += (unsigned)__builtin_popcountll(sm); eqn += (unsigned)__builtin_popcountll(em);
    }
}

DI void dsa_rows(const Ptrs& P, int b, int qb, float* slab, LAS unsigned char* lds, int wave, int lane);
DI void dsa_unit(const Ptrs& P, int b, int qb, float* slab, LAS unsigned char* lds, int wave, int lane) {
    const int r = lane & 31, h = lane >> 5, t0 = 32 * qb, tb = b * SEQ;
    {
        const _Float16* IQ = (const _Float16*)(P.ws + WS_IQ) + (size_t)(tb + t0 + r) * 512;
        const _Float16* IK = (const _Float16*)(P.ws + WS_IK) + (size_t)tb * 64;
        const float* IW = (const float*)(P.ws + WS_IW) + (size_t)(tb + t0 + r) * 8;
        LAS f16x8* QF = (LAS f16x8*)(lds + 81920);
#pragma unroll
        for (int s = 0; s < 4; ++s) QF[(wave * 4 + s) * 64 + lane] = *(const f16x8*)(IQ + wave * 64 + 16 * s + 8 * h);
        const f32x4 w03 = *(const f32x4*)IW, w47 = *(const f32x4*)(IW + 4);
        const float wv[8] = {w03.x, w03.y, w03.z, w03.w, w47.x, w47.y, w47.z, w47.w};
        __syncthreads();
#pragma unroll 1
        for (int kt = wave; kt <= qb; kt += NWAVES) {
            asm volatile("" ::: "memory");
            const _Float16* kr = IK + (size_t)(32 * kt + r) * 64 + 8 * h;
            f16x8 kf[4];
#pragma unroll
            for (int s = 0; s < 4; ++s) kf[s] = *(const f16x8*)(kr + 16 * s);
            f32x16 sc = zero16();
            f16x8 qn[4];
#pragma unroll
            for (int s = 0; s < 4; ++s) qn[s] = QF[s * 64 + lane];
#pragma unroll
            for (int hd = 0; hd < 8; ++hd) {
                f16x8 qc[4];
#pragma unroll
                for (int s = 0; s < 4; ++s) qc[s] = qn[s];
                if (hd < 7) {
#pragma unroll
                    for (int s = 0; s < 4; ++s) qn[s] = QF[((hd + 1) * 4 + s) * 64 + lane];
                }
                f32x16 a = zero16();
#pragma unroll
                for (int s = 0; s < 4; ++s) a = __builtin_amdgcn_mfma_f32_32x32x16_f16(kf[s], qc[s], a, 0, 0, 0);
#pragma unroll
                for (int i = 0; i < 16; ++i) sc[i] = fmaf(wv[hd], fmaxf(a[i], 0.f), sc[i]);
                __builtin_amdgcn_sched_barrier(0);
            }
            float* o = slab + (size_t)r * 4096 + 32 * kt + 4 * h;
#pragma unroll
            for (int g = 0; g < 4; ++g) *(f32x4*)(o + 8 * g) = (f32x4){sc[4 * g], sc[4 * g + 1], sc[4 * g + 2], sc[4 * g + 3]};
        }
    }
    __syncthreads();
    int lane2_ = lane; asm volatile("" : "+v"(lane2_));
    dsa_rows(P, b, qb, slab, lds, wave, lane2_);
    __syncthreads();
}

DI void dsa_rows(const Ptrs& P, int b, int qb, float* slab, LAS unsigned char* lds, int wave, int lane) {
    const int r = lane & 31, h = lane >> 5, t0 = 32 * qb, tb = b * SEQ;
    LAS unsigned* hist = (LAS unsigned*)(lds + wave * 8192);
    LAS char* vbuf2 = (LAS char*)(lds + wave * 8192);
    const bf16_t* AQ = (const bf16_t*)(P.ws + WS_AQ); const bf16_t* AK = (const bf16_t*)(P.ws + WS_AK) + (size_t)tb * 64; const bf16_t* AV = (const bf16_t*)(P.ws + WS_AV) + (size_t)tb * 64;
#pragma unroll 1
    for (int qq = 0; qq < 4; ++qq) {
        const int q = wave + 8 * qq, t = t0 + q, n = t + 1;
        LAS unsigned short* idx = (LAS unsigned short*)(lds + 65536 + q * 512);
        int cnt;
        if (n <= 256) { for (int i = lane; i < n; i += 64) idx[i] = (unsigned short)i; cnt = n; }
        else { select_top256(slab + (size_t)q * 4096, n, hist, idx, lane); cnt = 256; }
        bf16x8 qf[4];
#pragma unroll
        for (int s = 0; s < 4; ++s) { const bf16x8 z = {0, 0, 0, 0, 0, 0, 0, 0}; qf[s] = (r < 6) ? *(const bf16x8*)(AQ + (size_t)(tb + t) * 384 + r * 64 + 16 * s + 8 * h) : z; }
        OState S; S.o0 = zero16(); S.o1 = zero16(); S.m = -INFINITY; S.l = 0.f;
        const int nkt = (cnt + 31) >> 5;
#pragma unroll 1
        for (int kt = 0; kt < nkt; ++kt) {
            const int slot = 32 * kt + r;
            const int key = (slot < cnt) ? (int)idx[slot] : 0;
            LAS char* vbuf = vbuf2 + (kt & 1) * 4096;
            stage_v(vbuf, (const char*)(AV + (size_t)key * 64), lane);
            f32x16 st = qk_tile(qf, (const char*)(AK + (size_t)key * 64), h);
#pragma unroll
            for (int i = 0; i < 16; ++i) st[i] = (32 * kt + crow(i, h) < cnt) ? st[i] : -INFINITY;
            softmax_pv(S, st, vbuf, lane);
        }
        if (r < 6) store_ot(S, (bf16_t*)(P.ws + WS_O) + (size_t)(tb + t) * KMERGE + r * 64, h);
    }
}

DI void dsa_phase(const Ptrs& P, LAS unsigned char* lds, int wave, int lane) {
    bmerge_rows(P, wave, lane);
    float* slab = (float*)(P.ws + WS_SLAB) + (size_t)blockIdx.x * 32 * 4096;
    const int G = gridDim.x;
    for (int u = blockIdx.x; u < 1024; u += G) {
        const int p = u >> 8, wq = u & 255, b = wq & 7, k = wq >> 3;
        const int qb = (p == 0) ? k : (p == 1) ? 63 - k : (p == 2) ? 64 + k : 127 - k;
        dsa_unit(P, b, qb, slab, lds, wave, lane);
    }
}

DI void wconv_item(const float* W, int ldw, int srccol0, int nvalid, const float* gain, bf16_t* Bt, int K, int v0, int k0, LAS float* scr, int lane) {
    const int j = lane & 31;
#pragma unroll 8
    for (int i = 0; i < 32; ++i) {
        const int kk = 2 * i + (lane >> 5);
        float w = (j < nvalid) ? W[(size_t)(k0 + kk) * ldw + srccol0 + j] : 0.f;
        if (gain) w *= gain[k0 + kk];
        scr[kk * 33 + j] = w;
    }
    asm volatile("s_waitcnt lgkmcnt(0)" ::: "memory");
    const int c = lane & 7;
#pragma unroll
    for (int jj = 0; jj < 4; ++jj) {
        const int n = (lane >> 3) + 8 * jj; const LAS float* s = scr + (8 * c) * 33 + n;
        u32x4 o; o.x = pkbf(s[0 * 33], s[1 * 33]); o.y = pkbf(s[2 * 33], s[3 * 33]); o.z = pkbf(s[4 * 33], s[5 * 33]); o.w = pkbf(s[6 * 33], s[7 * 33]);
        *(u32x4*)(Bt + (size_t)(v0 + n) * K + k0 + 8 * c) = o;
    }
    asm volatile("s_waitcnt lgkmcnt(0)" ::: "memory");
}
DI int qkv_slot_src(int slot) {
    if (slot < 6) return 64 * slot;
    if (slot == 6) return 384;
    if (slot == 7) return 448;
    if (slot < 16) return 512 + 64 * (slot - 8);
    if (slot == 16) return 1024;
    if (slot == 17) return 1088;
    if (slot < 30) return 1096 + 64 * (slot - 18);
    if (slot < 42) return 1864 + 64 * (slot - 30);
    if (slot < 54) return 2632 + 64 * (slot - 42);
    if (slot < 62) return 3400 + 64 * (slot - 54);
    if (slot < 64) return 3912 + 64 * (slot - 62);
    if (slot < 66) return 4040 + 64 * (slot - 64);
    return -1;
}
DI void weights_phase(const Ptrs& P, int layer, LAS unsigned char* lds, int wave, int lane) {
    LAS float* scr = (LAS float*)(lds + wave * 16384);
    const int gw = blockIdx.x * NWAVES + wave, NGW = gridDim.x * NWAVES;
    const float* w_in = P.w_in + (size_t)layer * DM * IN_W; const float* an = P.attn_norm + layer * DM; const float* mn = P.mlp_norm + layer * DM;
    const float* w_a = P.w_a + (size_t)layer * 384 * DM; const float* w_b = P.w_b + (size_t)layer * 256 * DM; const float* w_c = P.w_c + (size_t)layer * 512 * DM;
    const float* w_o = P.w_o + (size_t)layer * DM * DM; const float* w_up = P.w_up + (size_t)layer * DM * FF; const float* w_dn = P.w_down + (size_t)layer * FF * DM;
    bf16_t* Wqkv = (bf16_t*)(P.ws + WS_WQKV); bf16_t* Wg = (bf16_t*)(P.ws + WS_WG); bf16_t* Wm = (bf16_t*)(P.ws + WS_WM); bf16_t* Wo = (bf16_t*)(P.ws + WS_WO);
    bf16_t* Wup = (bf16_t*)(P.ws + WS_WUP); bf16_t* Wdn = (bf16_t*)(P.ws + WS_WDN);
    constexpr int I_QKV = 16 * (NQKV / 32), I_G = 16 * (NGATE / 32), I_M = 18 * 32, I_O = 16 * 32, I_UP = 16 * (FF / 32), I_DN = 64 * 32;
    constexpr int NITEMS = I_QKV + I_G + I_M + I_O + I_UP + I_DN;
    for (int it = gw; it < NITEMS; it += NGW) {
        int x = it;
        if (x < I_QKV) { const int kb = x / (NQKV / 32), vb = x % (NQKV / 32); const int pn = vb >> 3, bj = (vb >> 2) & 1, wc = vb & 3, slot = 4 * pn + wc; const int src = qkv_slot_src(slot);
            int nvalid = 32; if (src < 0) nvalid = 0; else if (slot == 17) nvalid = bj ? 0 : 8;
            wconv_item(w_in, IN_W, (src < 0 ? 0 : src) + 32 * bj, nvalid, an, Wqkv, DM, 32 * vb, 64 * kb, scr, lane); continue; } x -= I_QKV;
        if (x < I_G) { const int kb = x / (NGATE / 32), vb = x % (NGATE / 32); wconv_item(w_in, IN_W, 4168 + 32 * vb, 32, an, Wg, DM, 32 * vb, 64 * kb, scr, lane); continue; } x -= I_G;
        if (x < I_M) { const int kb = x / 32, vb = x % 32, k0 = 64 * kb;
            const float* src = (k0 < 384) ? w_a + (size_t)k0 * DM : (k0 < 640) ? w_b + (size_t)(k0 - 384) * DM : w_c + (size_t)(k0 - 640) * DM;
            wconv_item(src - (size_t)k0 * DM, DM, 32 * vb, 32, nullptr, Wm, KMERGE, 32 * vb, k0, scr, lane); continue; } x -= I_M;
        if (x < I_O) { const int kb = x / 32, vb = x % 32; wconv_item(w_o, DM, 32 * vb, 32, nullptr, Wo, DM, 32 * vb, 64 * kb, scr, lane); continue; } x -= I_O;
        if (x < I_UP) { const int kb = x / (FF / 32), vb = x % (FF / 32); wconv_item(w_up, FF, 32 * vb, 32, mn, Wup, DM, 32 * vb, 64 * kb, scr, lane); continue; } x -= I_UP;
        { const int kb = x / 32, vb = x % 32; wconv_item(w_dn, DM, 32 * vb, 32, nullptr, Wdn, FF, 32 * vb, 64 * kb, scr, lane); }
    }
}

DI void sincos_d(double x, double& s, double& c) {
    const double k = __builtin_rint(x * 0.63661977236758134308);
    const double r0 = __builtin_fma(-k, 1.57079632679489655800e+00, x);
    const double r = __builtin_fma(-k, 6.12323399573676603587e-17, r0);
    const double z = r * r;
    double ps = -7.6471637318198164759e-13; ps = ps * z + 1.6059043836821614599e-10; ps = ps * z - 2.5052108385441718775e-08; ps = ps * z + 2.7557319223985890653e-06;
    ps = ps * z - 1.9841269841269841270e-04; ps = ps * z + 8.3333333333333333333e-03; ps = ps * z - 1.6666666666666666667e-01;
    const double sr = r + r * z * ps;
    double pc = 4.7794773323873852974e-14; pc = pc * z - 1.1470745597729724714e-11; pc = pc * z + 2.0876756987868098979e-09; pc = pc * z - 2.7557319223985890653e-07;
    pc = pc * z + 2.4801587301587301587e-05; pc = pc * z - 1.3888888888888888889e-03; pc = pc * z + 4.1666666666666666667e-02; pc = pc * z - 0.5;
    const double cr = 1.0 + z * pc;
    const int q = (int)((long long)k & 3);
    s = (q == 0) ? sr : (q == 1) ? cr : (q == 2) ? -sr : -cr;
    c = (q == 0) ? cr : (q == 1) ? -sr : (q == 2) ? -cr : sr;
}
DI void prologue_rows(const Ptrs& P, int wave, int lane) {
    const int gw = blockIdx.x * NWAVES + wave, NGW = gridDim.x * NWAVES;
    bf16_t* HB = (bf16_t*)(P.ws + WS_HB); float* SSQ = (float*)(P.ws + WS_SSQ); f32x2* CS = (f32x2*)(P.ws + WS_CS);
    const int fi = lane & 31;
    double invf = 1.0; { double bs = 0.74989420933245582730; int e = fi;
#pragma unroll
        for (int bit = 0; bit < 5; ++bit) { if (e & 1) invf *= bs; bs *= bs; e >>= 1; } }
    for (int m = gw; m < TOK; m += NGW) {
        const f32x4* xr = (const f32x4*)(P.x + (size_t)m * DM) + lane;
        f32x4 v[4]; float s = 0.f;
#pragma unroll
        for (int j = 0; j < 4; ++j) { v[j] = xr[64 * j]; s += (v[j].x * v[j].x + v[j].y * v[j].y) + (v[j].z * v[j].z + v[j].w * v[j].w); }
        s = wave_sum(s);
        u32x2* o8 = (u32x2*)(HB + (size_t)m * DM) + lane;
#pragma unroll
        for (int j = 0; j < 4; ++j) { u32x2 w; w.x = pkbf(v[j].x, v[j].y); w.y = pkbf(v[j].z, v[j].w); o8[64 * j] = w; }
        if (lane < 16) SSQ[(size_t)m * 16 + lane] = (lane == 0) ? s : 0.f;
        if (lane < 32) { double sn, cn; sincos_d((double)P.pos[m] * invf, sn, cn); CS[(size_t)m * 32 + fi] = (f32x2){(float)cn, (float)sn}; }
    }
}
DI void final_norm_rows(const Ptrs& P, int wave, int lane) {
    const int gw = blockIdx.x * NWAVES + wave, NGW = gridDim.x * NWAVES;
    const float* SSQ = (const float*)(P.ws + WS_SSQ);
    f32x4 g[4];
#pragma unroll
    for (int j = 0; j < 4; ++j) g[j] = ((const f32x4*)P.final_norm)[lane + 64 * j];
    for (int m = gw; m < TOK; m += NGW) {
        const float rs = pg8::row_rs(SSQ, m);
        f32x4* xr = (f32x4*)(P.out + (size_t)m * DM) + lane;
#pragma unroll
        for (int j = 0; j < 4; ++j) { f32x4 v = xr[64 * j]; xr[64 * j] = v * rs * g[j]; }
    }
}

struct Args { Ptrs p; int ph_lo, ph_hi; };
__global__ void __launch_bounds__(NWAVES * 64, 2) hybrid_fwd(Args args) {
    extern __shared__ __attribute__((aligned(16))) unsigned char lds_raw[];
    LAS unsigned char* lds = (LAS unsigned char*)lds_raw;
    const Ptrs& P = args.p;
    const int tid = threadIdx.x;
    volatile LAS unsigned* MISC = (volatile LAS unsigned*)(lds + MISC_OFF);
    for (int u = tid; u < (LDS_BYTES - LDSCTL_OFF) / 4; u += NWAVES * 64) ((LAS unsigned*)(lds + LDSCTL_OFF))[u] = 0u;
    __syncthreads();
    const int lo = args.ph_lo, hi = args.ph_hi;
    const bool multi = (hi - lo) > 1;
    XcdBarrier bar; bar.bar = (unsigned*)(P.ws + WS_CTL) + CW_BAR; bar.x = 0; bar.st = nullptr;
    if (multi) bar = xcd_barrier_post((unsigned*)(P.ws + WS_CTL) + CW_BAR, MISC + 8);
#ifdef ONLY_PHASE
#define IN(k) (((k) == 0 ? 0 : ((k) == 9 ? 0 : ((k) == 18 ? 18 : ((k) - 1) % 9 + 1))) == ONLY_PHASE && lo <= (k) && (k) < hi)
#else
#define IN(k) (lo <= (k) && (k) < hi)
#endif
#define SEAM(k) do { if (IN(k) && IN((k) + 1)) xcd_barrier(bar); } while (0)
    const int G = gridDim.x;
#define PHASE_IDS() int tid_p = threadIdx.x; asm volatile("" : "+v"(tid_p)); const int lane = tid_p & 63, wave = __builtin_amdgcn_readfirstlane(tid_p >> 6)
    const pg8::bf16_t* HB = (const pg8::bf16_t*)(P.ws + WS_HB);
    float* SSQ = (float*)(P.ws + WS_SSQ);

    if (IN(0)) { PHASE_IDS(); weights_phase(P, 0, lds, wave, lane); prologue_rows(P, wave, lane); SEAM(0); }
#pragma unroll 1
    for (int layer = 0; layer < DEPTH; ++layer) {
        const int pb = 1 + 9 * layer;
        if (layer == 1) { if (IN(9)) { PHASE_IDS(); weights_phase(P, 1, lds, wave, lane); SEAM(9); } }
        if (IN(pb + 0)) {
            pg8::Gemm g{HB, (const pg8::bf16_t*)(P.ws + WS_WQKV), TOK, NQKV, DM}; pg8::StaticOrder S; S.init(TOK, NQKV, G, (int)blockIdx.x);
            pg8::EpiQKV E; E.B.aq = (pg8::bf16_t*)(P.ws + WS_AQ); E.B.ak = (pg8::bf16_t*)(P.ws + WS_AK); E.B.av = (pg8::bf16_t*)(P.ws + WS_AV); E.B.iq = (pg8::bf16_t*)(P.ws + WS_IQ); E.B.ik = (pg8::bf16_t*)(P.ws + WS_IK);
            E.B.iw = (float*)(P.ws + WS_IW); E.B.bq = (pg8::bf16_t*)(P.ws + WS_BQ); E.B.bk = (pg8::bf16_t*)(P.ws + WS_BK); E.B.bv = (pg8::bf16_t*)(P.ws + WS_BV);
            E.B.cq = (pg8::bf16_t*)(P.ws + WS_CQ); E.B.ck = (pg8::bf16_t*)(P.ws + WS_CK); E.B.cv = (pg8::bf16_t*)(P.ws + WS_CV);
            E.ssq = SSQ; E.cs = (const pg8::f32x2*)(P.ws + WS_CS); E.iknorm = P.iknorm + layer * 64;
            pg8::gemm_phase<pg8::EpiQKV, pg8::StaticOrder, true, true>(lds, g, S, E);
            SEAM(pb + 0);
        }
        if (IN(pb + 1)) { PHASE_IDS(); attn_bc_phase(P, layer, lds, wave, lane); SEAM(pb + 1); }
        if (IN(pb + 2)) { PHASE_IDS(); dsa_phase(P, lds, wave, lane); SEAM(pb + 2); }
        if (IN(pb + 3)) {
            pg8::Gemm g{HB, (const pg8::bf16_t*)(P.ws + WS_WG), TOK, NGATE, DM}; pg8::StaticOrder S; S.init(TOK, NGATE, G, (int)blockIdx.x);
            pg8::EpiAct<0> E{(pg8::bf16_t*)(P.ws + WS_GATES), NGATE, SSQ};
            pg8::gemm_phase<pg8::EpiAct<0>, pg8::StaticOrder, true, true>(lds, g, S, E);
            SEAM(pb + 3);
        }
        if (IN(pb + 4)) {
            pg8::Gemm g{(const pg8::bf16_t*)(P.ws + WS_O), (const pg8::bf16_t*)(P.ws + WS_WM), TOK, DM, KMERGE}; pg8::StaticOrder S; S.init(TOK, DM, G, (int)blockIdx.x);
            pg8::EpiMerge E{(const pg8::bf16_t*)(P.ws + WS_GATES), (pg8::bf16_t*)(P.ws + WS_MERGED)};
            pg8::gemm_phase<pg8::EpiMerge, pg8::StaticOrder, true, true>(lds, g, S, E);
            SEAM(pb + 4);
        }
        if (IN(pb + 5)) {
            pg8::Gemm g{(const pg8::bf16_t*)(P.ws + WS_MERGED), (const pg8::bf16_t*)(P.ws + WS_WO), TOK, DM, DM}; pg8::StaticOrder S; S.init(TOK, DM, G, (int)blockIdx.x);
            pg8::EpiResid E{layer == 0 ? P.x : P.out, P.out, (pg8::bf16_t*)(P.ws + WS_HB), SSQ};
            pg8::gemm_phase<pg8::EpiResid, pg8::StaticOrder, true, true>(lds, g, S, E);
            SEAM(pb + 5);
        }
        if (IN(pb + 6)) {
            pg8::Gemm g{HB, (const pg8::bf16_t*)(P.ws + WS_WUP), TOK, FF, DM}; pg8::StaticOrder S; S.init(TOK, FF, G, (int)blockIdx.x);
            pg8::EpiAct<1> E{(pg8::bf16_t*)(P.ws + WS_HID), FF, SSQ};
            pg8::gemm_phase<pg8::EpiAct<1>, pg8::StaticOrder, true, true>(lds, g, S, E);
            SEAM(pb + 6);
        }
        if (IN(pb + 7)) {
            pg8::Gemm g{(const pg8::bf16_t*)(P.ws + WS_HID), (const pg8::bf16_t*)(P.ws + WS_WDN), TOK, DM, FF}; pg8::StaticOrder S; S.init(TOK, DM, G, (int)blockIdx.x);
            pg8::EpiResid E{P.out, P.out, (pg8::bf16_t*)(P.ws + WS_HB), SSQ};
            pg8::gemm_phase<pg8::EpiResid, pg8::StaticOrder, true, true>(lds, g, S, E);
            SEAM(pb + 7);
        }
    }
    if (IN(18)) { PHASE_IDS(); final_norm_rows(P, wave, lane); }
#undef IN
#undef SEAM
}

extern "C" void kernel_launch(void* const* d_in, const int* in_sizes, int n_in, void* d_out, int out_size, void* d_ws, size_t ws_size, hipStream_t stream) {
    static int grid = 0;
    if (grid == 0) {
        if (n_in != 14 || in_sizes[0] != TOK * DM || out_size != TOK * DM || ws_size < WS_END) {
            fprintf(stderr, "kernel_launch: built for 14 inputs, x/out of %d floats, >= %zu bytes of workspace; got n_in %d, in0 %d, out %d, ws %zu; nothing launched\n", TOK * DM, (size_t)WS_END, n_in, n_in > 0 ? in_sizes[0] : -1, out_size, ws_size);
            grid = -1; return; }
        int dev = 0, cus = 0, per_cu = 0;
        if (hipGetDevice(&dev) != hipSuccess || hipDeviceGetAttribute(&cus, hipDeviceAttributeMultiprocessorCount, dev) != hipSuccess) { grid = -1; return; }
        if (hipFuncSetAttribute((const void*)hybrid_fwd, hipFuncAttributeMaxDynamicSharedMemorySize, LDS_BYTES) != hipSuccess) { fprintf(stderr, "kernel_launch: hipFuncSetAttribute failed\n"); grid = -1; return; }
        if (hipOccupancyMaxActiveBlocksPerMultiprocessor(&per_cu, (const void*)hybrid_fwd, NWAVES * 64, LDS_BYTES) != hipSuccess || per_cu < 1) { fprintf(stderr, "kernel_launch: occupancy query says %d blocks per CU\n", per_cu); grid = -1; (void)hipGetLastError(); return; }
        (void)hipGetLastError();
        grid = cus;
        if (grid > 384) grid = 384;
    }
    if (grid < 0) return;
    if (hipMemsetAsync((char*)d_ws + WS_CTL, 0, CTL_ZERO_BYTES, stream) != hipSuccess) return;
    Args a{};
    a.p.x = (const float*)d_in[0]; a.p.pos = (const int*)d_in[1]; a.p.attn_norm = (const float*)d_in[2]; a.p.w_in = (const float*)d_in[3]; a.p.iknorm = (const float*)d_in[4];
    a.p.sinks = (const float*)d_in[5]; a.p.w_a = (const float*)d_in[6]; a.p.w_b = (const float*)d_in[7]; a.p.w_c = (const float*)d_in[8]; a.p.w_o = (const float*)d_in[9];
    a.p.mlp_norm = (const float*)d_in[10]; a.p.w_up = (const float*)d_in[11]; a.p.w_down = (const float*)d_in[12]; a.p.final_norm = (const float*)d_in[13];
    a.p.out = (float*)d_out; a.p.ws = (unsigned char*)d_ws;
#if MK_ONE_LAUNCH
    a.ph_lo = 0; a.ph_hi = N_PHASES;
    hipLaunchKernelGGL(hybrid_fwd, dim3(grid), dim3(NWAVES * 64), LDS_BYTES, stream, a);
#else
    for (int ph = 0; ph < N_PHASES; ++ph) { a.ph_lo = ph; a.ph_hi = ph + 1; hipLaunchKernelGGL(hybrid_fwd, dim3(grid), dim3(NWAVES * 64), LDS_BYTES, stream, a); }
#endif
}
```

```cpp
#include <hip/hip_runtime.h>
#include <cstdio>
#include <cstdint>
#ifndef PROBE_PHASE
#define PROBE_PHASE -1
#endif
#define SUBT(i, lds_) do { if (PROBE_PHASE >= 100 && blockIdx.x == 0 && threadIdx.x == 0) { volatile __attribute__((address_space(3))) unsigned long long* a_ = (volatile __attribute__((address_space(3))) unsigned long long*)((lds_) + 131072 + 2048); const unsigned long long n_ = __builtin_amdgcn_s_memrealtime(); a_[(i)] += n_ - a_[8]; a_[8] = n_; } } while (0)
namespace pg8 {
#define PG8_LAS __attribute__((address_space(3)))
typedef unsigned short bf16_t;
typedef short bf16x8 __attribute__((ext_vector_type(8)));
typedef float f32x4 __attribute__((ext_vector_type(4)));
typedef unsigned u32x4 __attribute__((ext_vector_type(4)));
constexpr int BM = 256, BK = 64, HALF = 128, HTB = HALF * BK * 2  , STAGE_BYTES = 8 * HTB, NXCD = 8, WGM = 8;

__host__ __device__ __forceinline__ int lds_byte(int r, int c) { const int st = (r >> 4) * 2 + (c >> 5), rr = r & 15, cc = c & 31, ob = rr * 64 + cc * 2; return st * 1024 + (ob ^ (((ob >> 9) & 1) << 5)); }
__host__ __device__ __forceinline__ void stage_rc(int b, int& R, int& C) { const int st = b / 1024, sb = b % 1024, swz = sb ^ (((sb >> 9) & 1) << 5); R = (st >> 1) * 16 + swz / 64; C = (st & 1) * 32 + (swz % 64) / 2; }
__host__ __device__ __forceinline__ int perm32(int rho) { const int n = rho >> 4, i = rho & 15; return 8 * (i >> 2) + 4 * n + (i & 3); }

struct Unit { int pm, pn; };
struct Gemm { const bf16_t* A; const bf16_t* Bt; int M, N, K; };

struct StaticOrder {
    int nM, nN, nwg, G, c;
    __host__ __device__ void init(int M, int N, int G_, int c_) { nM = M / BM; nN = N / BM; nwg = nM * nN; G = G_; c = c_; }
    __host__ __device__ bool next(int i, Unit& u) const {
        const long L = (long)i * G + c; if (L >= nwg) return false;
        int wgid = (int)L; { const int q = nwg / NXCD, r = nwg % NXCD, xcd = wgid % NXCD, off = wgid / NXCD; wgid = (xcd < r ? xcd * (q + 1) : r * (q + 1) + (xcd - r) * q) + off; }
        const int nig = WGM * nN, gid = wgid / nig, fm = gid * WGM, gsz = (nM - fm) < WGM ? (nM - fm) : WGM;
        u.pm = fm + ((wgid % nig) % gsz); u.pn = (wgid % nig) / gsz; return true;
    }
    __device__ __forceinline__ void a_ready(const Unit&) const {}
    __device__ __forceinline__ void done(const Unit&) const {}
};

__device__ __forceinline__ int opaque_lane() { unsigned z = 0u; asm volatile("" : "+v"(z)); return (int)__builtin_amdgcn_mbcnt_hi(~0u, __builtin_amdgcn_mbcnt_lo(~0u, z)); }
typedef float f32x2 __attribute__((ext_vector_type(2)));
typedef __bf16 bf16x2_t __attribute__((ext_vector_type(2)));
typedef _Float16 f16x2_t __attribute__((ext_vector_type(2)));
__device__ __forceinline__ unsigned pkbf(float lo, float hi) { f32x2 v = {lo, hi}; bf16x2_t b = __builtin_convertvector(v, bf16x2_t); return __builtin_bit_cast(unsigned, b); }
__device__ __forceinline__ unsigned pkh(float lo, float hi) { f32x2 v = {lo, hi}; f16x2_t b = __builtin_convertvector(v, f16x2_t); return __builtin_bit_cast(unsigned, b); }
__device__ __forceinline__ float bflo(unsigned u) { return __builtin_bit_cast(float, u << 16); }
__device__ __forceinline__ float bfhi(unsigned u) { return __builtin_bit_cast(float, u & 0xffff0000u); }
constexpr int DMODEL = 1024;
constexpr float NORM_EPS = 1e-6f;
constexpr float QSCALE = 0.125f * 1.4426950408889634f;

__device__ __forceinline__ float row_rs(const float* ssq, int row) {
    const f32x4* p = (const f32x4*)(ssq + (size_t)row * 16);
    const f32x4 a = p[0], b = p[1], c = p[2], d = p[3];
    const float s = ((a.x + a.y) + (a.z + a.w)) + ((b.x + b.y) + (b.z + b.w)) + ((c.x + c.y) + (c.z + c.w)) + ((d.x + d.y) + (d.z + d.w));
    return 1.0f / sqrtf(s * (1.0f / DMODEL) + NORM_EPS);
}

__device__ __forceinline__ void wave_row_rs(const float* ssq, int rowbase  , int fr, int fq, float (&rs)[2][4]) {
    const int ai0 = fq >> 1, m0 = 2 * (fq & 1);
    const float ra = row_rs(ssq, rowbase + ai0 * HALF + m0 * 16), rb = row_rs(ssq, rowbase + ai0 * HALF + (m0 + 1) * 16);
#pragma unroll
    for (int ai = 0; ai < 2; ++ai)
#pragma unroll
        for (int m = 0; m < 4; ++m) { const int src = fr + 16 * (2 * ai + (m >> 1)); rs[ai][m] = __shfl((m & 1) ? rb : ra, src); }
}

struct QkvBufs { bf16_t *aq, *ak, *av, *iq, *ik, *bq, *bk, *bv, *cq, *ck, *cv; float* iw; };
struct EpiQKV {
    static constexpr bool PERM = true, AFTER_DRAIN = false, KHOOK = false; static constexpr int HOOK_T0 = -1, HOOK_T1 = -1;
    QkvBufs B; const float* ssq; const f32x2* cs; const float* iknorm;
    __device__ __forceinline__ void operator()(const f32x4 (&acc)[2][2][4][2], const Unit& u_, int wr, int wc, int fr_, int fq_) const {
        Unit u = u_; asm volatile("" : "+s"(u.pm), "+s"(u.pn)); const int ln_ = opaque_lane(); const int fr = ln_ & 15, fq = ln_ >> 4;
        const int slot = u.pn * 4 + wc;
        if (slot >= 66) return;
        int kind, pitch; bf16_t* dst; float scale = 1.f;
        if (slot < 6)        { kind = 1; dst = B.aq + slot * 64; pitch = 384; scale = QSCALE; }
        else if (slot == 6)  { kind = 1; dst = B.ak; pitch = 64; }
        else if (slot == 7)  { kind = 0; dst = B.av; pitch = 64; }
        else if (slot < 16)  { kind = 2; dst = B.iq + (slot - 8) * 64; pitch = 512; }
        else if (slot == 16) { kind = 3; dst = B.ik; pitch = 64; }
        else if (slot == 17) { kind = 4; dst = nullptr; pitch = 0; }
        else if (slot < 30)  { kind = 1; dst = B.bq + (slot - 18) * 64; pitch = 768; scale = QSCALE; }
        else if (slot < 42)  { kind = 1; dst = B.bk + (slot - 30) * 64; pitch = 768; }
        else if (slot < 54)  { kind = 0; dst = B.bv + (slot - 42) * 64; pitch = 768; }
        else if (slot < 62)  { kind = 1; dst = B.cq + (slot - 54) * 64; pitch = 512; scale = QSCALE; }
        else if (slot < 64)  { kind = 1; dst = B.ck + (slot - 62) * 64; pitch = 128; }
        else                 { kind = 0; dst = B.cv + (slot - 64) * 64; pitch = 128; }
        float rsv[2][4]; wave_row_rs(ssq, u.pm * BM + wr * 64 + fr, fr, fq, rsv);
#pragma unroll
        for (int ai = 0; ai < 2; ++ai)
#pragma unroll
            for (int m = 0; m < 4; ++m) {
                if ((m & 1) == 0) __builtin_amdgcn_sched_barrier(0);
                const int row = u.pm * BM + ai * HALF + wr * 64 + m * 16 + fr;
                const float rs = rsv[ai][m] * scale;
                f32x4 a0 = acc[ai][0][m][0] * rs, a1 = acc[ai][0][m][1] * rs, b0 = acc[ai][1][m][0] * rs, b1 = acc[ai][1][m][1] * rs;
                if (kind == 4) { if (fq == 0) { float* o = B.iw + (size_t)row * 8; *(f32x4*)o = a0; *(f32x4*)(o + 4) = a1; } continue; }
                if (kind == 3) {
                    float s = (a0.x * a0.x + a0.y * a0.y) + (a0.z * a0.z + a0.w * a0.w) + (a1.x * a1.x + a1.y * a1.y) + (a1.z * a1.z + a1.w * a1.w)
                            + (b0.x * b0.x + b0.y * b0.y) + (b0.z * b0.z + b0.w * b0.w) + (b1.x * b1.x + b1.y * b1.y) + (b1.z * b1.z + b1.w * b1.w);
                    s += __shfl_xor(s, 16); s += __shfl_xor(s, 32);
                    const float r2 = 1.0f / sqrtf(s * (1.0f / 64.f) + NORM_EPS);
                    a0 = a0 * r2 * *(const f32x4*)(iknorm + 8 * fq); a1 = a1 * r2 * *(const f32x4*)(iknorm + 8 * fq + 4); b0 = b0 * r2 * *(const f32x4*)(iknorm + 32 + 8 * fq); b1 = b1 * r2 * *(const f32x4*)(iknorm + 32 + 8 * fq + 4);
                }
                if (kind != 0) {
                    const f32x4* cp = (const f32x4*)(cs + (size_t)row * 32 + 8 * fq);
                    const f32x4 c0 = cp[0], c1 = cp[1], c2 = cp[2], c3 = cp[3];
                    f32x4 na0, na1, nb0, nb1;
                    na0.x = a0.x * c0.x - b0.x * c0.y; nb0.x = b0.x * c0.x + a0.x * c0.y;
                    na0.y = a0.y * c0.z - b0.y * c0.w; nb0.y = b0.y * c0.z + a0.y * c0.w;
                    na0.z = a0.z * c1.x - b0.z * c1.y; nb0.z = b0.z * c1.x + a0.z * c1.y;
                    na0.w = a0.w * c1.z - b0.w * c1.w; nb0.w = b0.w * c1.z + a0.w * c1.w;
                    na1.x = a1.x * c2.x - b1.x * c2.y; nb1.x = b1.x * c2.x + a1.x * c2.y;
                    na1.y = a1.y * c2.z - b1.y * c2.w; nb1.y = b1.y * c2.z + a1.y * c2.w;
                    na1.z = a1.z * c3.x - b1.z * c3.y; nb1.z = b1.z * c3.x + a1.z * c3.y;
                    na1.w = a1.w * c3.z - b1.w * c3.w; nb1.w = b1.w * c3.z + a1.w * c3.w;
                    a0 = na0; a1 = na1; b0 = nb0; b1 = nb1;
                }
                u32x4 wa, wb;
                if (kind >= 2) { wa.x = pkh(a0.x, a0.y); wa.y = pkh(a0.z, a0.w); wa.z = pkh(a1.x, a1.y); wa.w = pkh(a1.z, a1.w); wb.x = pkh(b0.x, b0.y); wb.y = pkh(b0.z, b0.w); wb.z = pkh(b1.x, b1.y); wb.w = pkh(b1.z, b1.w); }
                else           { wa.x = pkbf(a0.x, a0.y); wa.y = pkbf(a0.z, a0.w); wa.z = pkbf(a1.x, a1.y); wa.w = pkbf(a1.z, a1.w); wb.x = pkbf(b0.x, b0.y); wb.y = pkbf(b0.z, b0.w); wb.z = pkbf(b1.x, b1.y); wb.w = pkbf(b1.z, b1.w); }
#ifdef FULL_LINE_ST
                {
                    const bool lo8 = fr < 8;
                    u32x4 x, y;
                    x.x = lo8 ? wb.x : wa.x; x.y = lo8 ? wb.y : wa.y; x.z = lo8 ? wb.z : wa.z; x.w = lo8 ? wb.w : wa.w;
                    y.x = (unsigned)__builtin_amdgcn_update_dpp(0, (int)x.x, 0x128, 0xf, 0xf, true); y.y = (unsigned)__builtin_amdgcn_update_dpp(0, (int)x.y, 0x128, 0xf, 0xf, true);
                    y.z = (unsigned)__builtin_amdgcn_update_dpp(0, (int)x.z, 0x128, 0xf, 0xf, true); y.w = (unsigned)__builtin_amdgcn_update_dpp(0, (int)x.w, 0x128, 0xf, 0xf, true);
                    u32x4 s1, s2;
                    s1.x = lo8 ? wa.x : y.x; s1.y = lo8 ? wa.y : y.y; s1.z = lo8 ? wa.z : y.z; s1.w = lo8 ? wa.w : y.w;
                    s2.x = lo8 ? y.x : wb.x; s2.y = lo8 ? y.y : wb.y; s2.z = lo8 ? y.z : wb.z; s2.w = lo8 ? y.w : wb.w;
                    const int rbase = row - fr + (fr & 7);
                    bf16_t* o1 = dst + (size_t)rbase * pitch + 8 * fq + (lo8 ? 0 : 32);
                    *(u32x4*)o1 = s1; *(u32x4*)(o1 + (size_t)8 * pitch) = s2;
                }
#else
                bf16_t* o = dst + (size_t)row * pitch + 8 * fq;
                *(u32x4*)o = wa; *(u32x4*)(o + 32) = wb;
#endif
            }
    }
};

template <int ACT> struct EpiAct {
    static constexpr bool PERM = true, AFTER_DRAIN = false, KHOOK = false; static constexpr int HOOK_T0 = -1, HOOK_T1 = -1;
    bf16_t* O; int ldc; const float* ssq;
    __device__ __forceinline__ float act(float v) const {
        if (ACT == 0) { const float e = __builtin_amdgcn_exp2f(-1.4426950408889634f * v); const float g = __builtin_amdgcn_rcpf(1.0f + e); return fmaxf(g, 1e-20f); }
        const float r = fmaxf(v, 0.f); return r * r;
    }
    __device__ __forceinline__ void operator()(const f32x4 (&acc)[2][2][4][2], const Unit& u_, int wr, int wc, int fr_, int fq_) const {
        Unit u = u_; asm volatile("" : "+s"(u.pm), "+s"(u.pn)); const int ln_ = opaque_lane(); const int fr = ln_ & 15, fq = ln_ >> 4;
        const int col0 = u.pn * BM + wc * 32 + 8 * fq;
        float rsv[2][4]; wave_row_rs(ssq, u.pm * BM + wr * 64 + fr, fr, fq, rsv);
#pragma unroll
        for (int ai = 0; ai < 2; ++ai)
#pragma unroll
            for (int m = 0; m < 4; ++m) {
                const int row = u.pm * BM + ai * HALF + wr * 64 + m * 16 + fr;
                const float rs = rsv[ai][m];
                bf16_t* rowp = O + (size_t)row * ldc + col0;
#pragma unroll
                for (int bj = 0; bj < 2; ++bj) {
                    const f32x4 v0 = acc[ai][bj][m][0] * rs, v1 = acc[ai][bj][m][1] * rs;
                    u32x4 w; w.x = pkbf(act(v0.x), act(v0.y)); w.y = pkbf(act(v0.z), act(v0.w)); w.z = pkbf(act(v1.x), act(v1.y)); w.w = pkbf(act(v1.z), act(v1.w));
                    *(u32x4*)(rowp + bj * HALF) = w;
                }
            }
    }
};

struct EpiResid {
    static constexpr bool PERM = true, AFTER_DRAIN = false, KHOOK = false; static constexpr int HOOK_T0 = -1, HOOK_T1 = -1;
    bf16_t* hb; float* ssq;
    __device__ __forceinline__ void operator()(const f32x4 (&acc)[2][2][4][2], const Unit& u_, int wr, int wc, int fr_, int fq_) const {
        Unit u = u_; asm volatile("" : "+s"(u.pm), "+s"(u.pn)); const int ln_ = opaque_lane(); const int fr = ln_ & 15, fq = ln_ >> 4;
        const int col0 = u.pn * BM + wc * 32 + 8 * fq;
#pragma unroll
        for (int ai = 0; ai < 2; ++ai)
#pragma unroll
            for (int m = 0; m < 4; ++m) {
                const int row = u.pm * BM + ai * HALF + wr * 64 + m * 16 + fr;
                float ss = 0.f;
#pragma unroll
                for (int bj = 0; bj < 2; ++bj) {
                    const size_t off = (size_t)row * DMODEL + col0 + bj * HALF;
                    const u32x4 hv = *(const u32x4*)(hb + off);
                    const f32x4 a0 = acc[ai][bj][m][0], a1 = acc[ai][bj][m][1];
                    u32x4 w; w.x = pkbf(a0.x + bflo(hv.x), a0.y + bfhi(hv.x)); w.y = pkbf(a0.z + bflo(hv.y), a0.w + bfhi(hv.y));
                    w.z = pkbf(a1.x + bflo(hv.z), a1.y + bfhi(hv.z)); w.w = pkbf(a1.z + bflo(hv.w), a1.w + bfhi(hv.w));
                    *(u32x4*)(hb + off) = w;
                    const float r0 = bflo(w.x), r1 = bfhi(w.x), r2 = bflo(w.y), r3 = bfhi(w.y), r4 = bflo(w.z), r5 = bfhi(w.z), r6 = bflo(w.w), r7 = bfhi(w.w);
                    ss += (r0 * r0 + r1 * r1) + (r2 * r2 + r3 * r3) + (r4 * r4 + r5 * r5) + (r6 * r6 + r7 * r7);
                }
                ss += __shfl_xor(ss, 16); ss += __shfl_xor(ss, 32);
                if (fq == 0) ssq[(size_t)row * 16 + u.pn * 4 + wc] = ss;
            }
    }
};

struct EpiMerge {
    static constexpr bool PERM = true, AFTER_DRAIN = false, KHOOK = true; static constexpr int HOOK_T0 = 6, HOOK_T1 = 10;
    const bf16_t* gates; bf16_t* merged;
    __device__ __forceinline__ void khook(f32x4 (&acc)[2][2][4][2], const Unit& u_, int t, int wr, int wc, int fr_, int fq_) const {
        Unit u = u_; asm volatile("" : "+s"(u.pm), "+s"(u.pn)); const int ln_ = opaque_lane(); const int fr = ln_ & 15, fq = ln_ >> 4;
        const int col0 = u.pn * BM + wc * 32 + 8 * fq; const int bi = (t == HOOK_T0) ? 0 : 1;
        u32x4 ga[2][2][2], gb[2][2][2];
        auto ldc = [&](int slot, int ch) {
            const int ai = ch >> 1, mb = 2 * (ch & 1);
#pragma unroll
            for (int mm = 0; mm < 2; ++mm)
#pragma unroll
                for (int bj = 0; bj < 2; ++bj) {
                    const int row = u.pm * BM + ai * HALF + wr * 64 + (mb + mm) * 16 + fr;
                    const bf16_t* gp = gates + (size_t)row * 3072 + bi * 1024 + col0 + bj * HALF;
                    ga[slot][mm][bj] = *(const u32x4*)gp; gb[slot][mm][bj] = *(const u32x4*)(gp + 1024);
                }
        };
        ldc(0, 0);
#pragma unroll
        for (int ch = 0; ch < 4; ++ch) {
            const int ai = ch >> 1, mb = 2 * (ch & 1), sl = ch & 1;
            if (ch < 3) ldc(sl ^ 1, ch + 1);
#pragma unroll
            for (int mm = 0; mm < 2; ++mm)
#pragma unroll
                for (int bj = 0; bj < 2; ++bj) {
                    const int m = mb + mm;
                    const u32x4 a = ga[sl][mm][bj], b = gb[sl][mm][bj];
                    f32x4 r0, r1;
                    r0.x = bflo(a.x) * __builtin_amdgcn_rcpf(bflo(b.x)); r0.y = bfhi(a.x) * __builtin_amdgcn_rcpf(bfhi(b.x));
                    r0.z = bflo(a.y) * __builtin_amdgcn_rcpf(bflo(b.y)); r0.w = bfhi(a.y) * __builtin_amdgcn_rcpf(bfhi(b.y));
                    r1.x = bflo(a.z) * __builtin_amdgcn_rcpf(bflo(b.z)); r1.y = bfhi(a.z) * __builtin_amdgcn_rcpf(bfhi(b.z));
                    r1.z = bflo(a.w) * __builtin_amdgcn_rcpf(bflo(b.w)); r1.w = bfhi(a.w) * __builtin_amdgcn_rcpf(bfhi(b.w));
                    acc[ai][bj][m][0] = acc[ai][bj][m][0] * r0; acc[ai][bj][m][1] = acc[ai][bj][m][1] * r1;
                }
            __builtin_amdgcn_sched_barrier(0);
        }
    }
    __device__ __forceinline__ void operator()(const f32x4 (&acc)[2][2][4][2], const Unit& u_, int wr, int wc, int fr_, int fq_) const {
        Unit u = u_; asm volatile("" : "+s"(u.pm), "+s"(u.pn)); const int ln_ = opaque_lane(); const int fr = ln_ & 15, fq = ln_ >> 4;
        const int col0 = u.pn * BM + wc * 32 + 8 * fq;
#pragma unroll
        for (int ai = 0; ai < 2; ++ai)
#pragma unroll
            for (int m = 0; m < 4; ++m) {
                const int row = u.pm * BM + ai * HALF + wr * 64 + m * 16 + fr;
#pragma unroll
                for (int bj = 0; bj < 2; ++bj) {
                    const u32x4 g = *(const u32x4*)(gates + (size_t)row * 3072 + 2048 + col0 + bj * HALF);
                    const f32x4 a0 = acc[ai][bj][m][0], a1 = acc[ai][bj][m][1];
                    u32x4 w; w.x = pkbf(a0.x * bflo(g.x), a0.y * bfhi(g.x)); w.y = pkbf(a0.z * bflo(g.y), a0.w * bfhi(g.y));
                    w.z = pkbf(a1.x * bflo(g.z), a1.y * bfhi(g.z)); w.w = pkbf(a1.z * bflo(g.w), a1.w * bfhi(g.w));
                    *(u32x4*)(merged + (size_t)row * DMODEL + col0 + bj * HALF) = w;
                }
            }
    }
};
template <class Epi, class Sched, bool ALIGN_EPI = false, bool SP2 = false>
__device__ __forceinline__ void gemm_phase(PG8_LAS unsigned char* lds, const Gemm g, const Sched& S, const Epi& E, const int wid_in) {
    const int tid = wid_in * 64 + opaque_lane(), wid = wid_in       , lane = tid & 63, wr = wid >> 2, wc = wid & 3, fr = lane & 15, fq = lane >> 4;
    const int K = g.K, nt = K / BK;
    unsigned voffA[2], voffB[2];
#pragma unroll
    for (int i = 0; i < 2; ++i) { int R, C; stage_rc(tid * 16 + i * 8192, R, C); const int Rb = Epi::PERM ? ((R & ~31) + perm32(R & 31)) : R;
        voffA[i] = (unsigned)(R * K + C) * 2u; voffB[i] = (unsigned)(Rb * K + C) * 2u; }
    const size_t kstep = (size_t)(BK * 2);
    const size_t hstep = (size_t)HALF * K * 2;
    const size_t tstep = 2 * hstep;
    const unsigned ldsw = (unsigned)wid * 1024u;
    const int aoff = lds_byte(wr * 64 + fr, fq * 8), boff = lds_byte(wc * 32 + fr, fq * 8);
#define PG8_SA(b, h) (((b) * 2 + (h)) * HTB)
#define PG8_SB(b, h) ((4 + (b) * 2 + (h)) * HTB)
#define PG8_STAGE(bufoff, gbase, voff) do { _Pragma("unroll") for (int _i = 0; _i < 2; ++_i) \
        __builtin_amdgcn_global_load_lds((const unsigned*)((const char*)(gbase) + (voff)[_i]), (PG8_LAS unsigned*)(lds + (bufoff) + ldsw + _i * 8192), 16, 0, 0); } while (0)
#define PG8_LDA(dst, b, h) do { _Pragma("unroll") for (int m = 0; m < 4; ++m) _Pragma("unroll") for (int k = 0; k < 2; ++k) dst[m][k] = *(const PG8_LAS bf16x8*)(lds + PG8_SA(b, h) + aoff + m * 2048 + k * 1024); } while (0)
#define PG8_LDB(dst, b, h) do { _Pragma("unroll") for (int n = 0; n < 2; ++n) _Pragma("unroll") for (int k = 0; k < 2; ++k) dst[n][k] = *(const PG8_LAS bf16x8*)(lds + PG8_SB(b, h) + boff + n * 2048 + k * 1024); } while (0)
#define PG8_MMA(ai, bj, At, Bt) do { __builtin_amdgcn_s_setprio(1); _Pragma("unroll") for (int m = 0; m < 4; ++m) _Pragma("unroll") for (int n = 0; n < 2; ++n) _Pragma("unroll") for (int k = 0; k < 2; ++k) \
        acc[ai][bj][m][n] = __builtin_amdgcn_mfma_f32_16x16x32_bf16(Bt[n][k], At[m][k], acc[ai][bj][m][n], 0, 0, 0); __builtin_amdgcn_s_setprio(0); } while (0)
#define PG8_WAIT_V(n) asm volatile("s_waitcnt vmcnt(" #n ")" ::: "memory")
#define PG8_WAIT_L(n) asm volatile("s_waitcnt lgkmcnt(" #n ")" ::: "memory")
#define PG8_BAR __builtin_amdgcn_s_barrier()
#define PG8_SCHED __builtin_amdgcn_sched_barrier(0)
    Unit cur, nxt; int ui = 0;
    if (!S.next(0, cur)) return;
    f32x4 acc[2][2][4][2];
#pragma unroll
    for (int a = 0; a < 2; ++a)
#pragma unroll
        for (int b = 0; b < 2; ++b)
#pragma unroll
            for (int m = 0; m < 4; ++m)
#pragma unroll
                for (int n = 0; n < 2; ++n) acc[a][b][m][n] = (f32x4){0.f, 0.f, 0.f, 0.f};
    bf16x8 At[4][2], B0[2][2], B1[2][2];
    const char* cA = (const char*)g.A + (size_t)cur.pm * tstep; const char* cB = (const char*)g.Bt + (size_t)cur.pn * tstep;
    S.a_ready(cur);
    if constexpr (SP2) {
        PG8_STAGE(PG8_SB(0, 0), cB, voffB); PG8_STAGE(PG8_SB(0, 1), cB + hstep, voffB); PG8_STAGE(PG8_SA(0, 0), cA, voffA); PG8_STAGE(PG8_SA(0, 1), cA + hstep, voffA);
        if (wr == 1) PG8_BAR;
        PG8_WAIT_V(2); PG8_BAR;
        PG8_STAGE(PG8_SB(1, 0), cB + kstep, voffB); PG8_STAGE(PG8_SA(1, 0), cA + kstep, voffA); PG8_STAGE(PG8_SB(1, 1), cB + hstep + kstep, voffB);
        PG8_WAIT_V(6); PG8_BAR;
    } else {
        PG8_STAGE(PG8_SB(0, 0), cB, voffB); PG8_STAGE(PG8_SA(0, 0), cA, voffA); PG8_STAGE(PG8_SB(0, 1), cB + hstep, voffB); PG8_STAGE(PG8_SA(0, 1), cA + hstep, voffA);
        if (wr == 1) PG8_BAR;
        PG8_WAIT_V(4); PG8_BAR;
        PG8_STAGE(PG8_SB(1, 0), cB + kstep, voffB); PG8_STAGE(PG8_SA(1, 0), cA + kstep, voffA); PG8_STAGE(PG8_SB(1, 1), cB + hstep + kstep, voffB);
        PG8_WAIT_V(6); PG8_BAR;
    }
    for (;;) {
        const bool has_next = S.next(ui + 1, nxt);
        const char* nA = has_next ? (const char*)g.A + (size_t)nxt.pm * tstep : cA; const char* nB = has_next ? (const char*)g.Bt + (size_t)nxt.pn * tstep : cB;
        for (int t = 0; t < nt; t += 2) {
            if constexpr (Epi::KHOOK) { if (t == Epi::HOOK_T0 || t == Epi::HOOK_T1) E.khook(acc, cur, t, wr, wc, fr, fq); }
            const bool last = (t == nt - 2);
            const char* a1 = cA + (size_t)(t + 1) * kstep;
            const char* a2 = last ? nA : cA + (size_t)(t + 2) * kstep; const char* b2 = last ? nB : cB + (size_t)(t + 2) * kstep;
            const char* a3 = a2 + kstep; const char* b3 = b2 + kstep;
            if (last && has_next) S.a_ready(nxt);
            if constexpr (SP2) {
            PG8_LDB(B0, 0, 0); PG8_LDB(B1, 0, 1); PG8_SCHED; PG8_LDA(At, 0, 0); PG8_STAGE(PG8_SA(1, 1), a1 + hstep, voffA);
            PG8_WAIT_V(8); PG8_WAIT_L(0); PG8_BAR; PG8_MMA(0, 0, At, B0); PG8_MMA(0, 1, At, B1); PG8_BAR; PG8_SCHED;
            PG8_LDA(At, 0, 1); PG8_STAGE(PG8_SB(0, 0), b2, voffB); PG8_STAGE(PG8_SB(0, 1), b2 + hstep, voffB); PG8_STAGE(PG8_SA(0, 0), a2, voffA);
            PG8_WAIT_V(8); PG8_WAIT_L(0); PG8_BAR; PG8_MMA(1, 0, At, B0); PG8_MMA(1, 1, At, B1); PG8_BAR; PG8_SCHED;
            PG8_LDB(B0, 1, 0); PG8_LDB(B1, 1, 1); PG8_SCHED; PG8_LDA(At, 1, 0); PG8_STAGE(PG8_SA(0, 1), a2 + hstep, voffA);
            PG8_WAIT_V(8); PG8_WAIT_L(0); PG8_BAR; PG8_MMA(0, 0, At, B0); PG8_MMA(0, 1, At, B1); PG8_BAR; PG8_SCHED;
            PG8_LDA(At, 1, 1); PG8_STAGE(PG8_SB(1, 0), b3, voffB); PG8_STAGE(PG8_SB(1, 1), b3 + hstep, voffB); PG8_STAGE(PG8_SA(1, 0), a3, voffA);
            PG8_WAIT_V(8); PG8_WAIT_L(0); PG8_BAR; PG8_MMA(1, 0, At, B0); PG8_MMA(1, 1, At, B1); PG8_BAR; PG8_SCHED;
            } else {
            PG8_LDB(B0, 0, 0); PG8_SCHED; PG8_LDA(At, 0, 0); PG8_STAGE(PG8_SA(1, 1), a1 + hstep, voffA);
            PG8_WAIT_L(8); PG8_BAR; PG8_WAIT_L(0); PG8_MMA(0, 0, At, B0); PG8_BAR; PG8_SCHED;
            PG8_LDB(B1, 0, 1); PG8_STAGE(PG8_SB(0, 0), b2, voffB);
            PG8_BAR; PG8_WAIT_L(0); PG8_MMA(0, 1, At, B1); PG8_BAR;
            PG8_LDA(At, 0, 1); PG8_STAGE(PG8_SA(0, 0), a2, voffA);
            PG8_BAR; PG8_WAIT_L(0); PG8_MMA(1, 0, At, B0); PG8_BAR; PG8_SCHED;
            PG8_STAGE(PG8_SB(0, 1), b2 + hstep, voffB);
            PG8_WAIT_V(6); PG8_BAR; PG8_MMA(1, 1, At, B1); PG8_BAR;
            PG8_LDB(B0, 1, 0); PG8_SCHED; PG8_LDA(At, 1, 0); PG8_STAGE(PG8_SA(0, 1), a2 + hstep, voffA);
            PG8_WAIT_L(8); PG8_BAR; PG8_WAIT_L(0); PG8_MMA(0, 0, At, B0); PG8_BAR; PG8_SCHED;
            PG8_LDB(B1, 1, 1); PG8_STAGE(PG8_SB(1, 0), b3, voffB);
            PG8_BAR; PG8_WAIT_L(0); PG8_MMA(0, 1, At, B1); PG8_BAR;
            PG8_LDA(At, 1, 1); PG8_STAGE(PG8_SA(1, 0), a3, voffA);
            PG8_BAR; PG8_WAIT_L(0); PG8_MMA(1, 0, At, B0); PG8_BAR; PG8_SCHED;
            PG8_STAGE(PG8_SB(1, 1), b3 + hstep, voffB);
            PG8_WAIT_V(6); PG8_BAR; PG8_MMA(1, 1, At, B1); PG8_BAR;
            }
        }
        if constexpr (ALIGN_EPI) { if (wr == 0) PG8_BAR; }
        SUBT(9, lds);
        if constexpr (!Epi::AFTER_DRAIN) { E(acc, cur, wr, wc, fr, fq); S.done(cur); }
        SUBT(10, lds);
        if (!has_next) break;
#pragma unroll
        for (int a = 0; a < 2; ++a)
#pragma unroll
            for (int b = 0; b < 2; ++b)
#pragma unroll
                for (int m = 0; m < 4; ++m)
#pragma unroll
                    for (int n = 0; n < 2; ++n) acc[a][b][m][n] = (f32x4){0.f, 0.f, 0.f, 0.f};
        cur = nxt; cA = nA; cB = nB; ++ui;
        if constexpr (ALIGN_EPI) { if (wr == 1) PG8_BAR; }
    }
    PG8_WAIT_V(0);
    if constexpr (!ALIGN_EPI) { if (wr == 0) PG8_BAR; }
    PG8_BAR;
    if constexpr (Epi::AFTER_DRAIN) { E.fused(acc, cur, wr, wc, fr, fq, lds, wid, lane); S.done(cur); }
#undef PG8_SA
#undef PG8_SB
#undef PG8_STAGE
#undef PG8_LDA
#undef PG8_LDB
#undef PG8_MMA
#undef PG8_WAIT_V
#undef PG8_WAIT_L
#undef PG8_BAR
#undef PG8_SCHED
}
}
#define GAS __attribute__((address_space(1)))
#define LAS __attribute__((address_space(3)))
typedef unsigned short bf16;
typedef unsigned v4u __attribute__((ext_vector_type(4)));
typedef float f32x4 __attribute__((ext_vector_type(4)));
typedef short bf16x8 __attribute__((ext_vector_type(8)));
typedef GAS unsigned gu32;
typedef GAS unsigned long long gu64;
#define RLX_AGENT __ATOMIC_RELAXED, __HIP_MEMORY_SCOPE_AGENT
#define LDS_WAIT() asm volatile("s_waitcnt lgkmcnt(0)" ::: "memory")
#define VM_WAIT() asm volatile("s_waitcnt vmcnt(0)" ::: "memory")
__device__ __forceinline__ unsigned long long rt() { return __builtin_amdgcn_s_memrealtime(); }
__device__ __forceinline__ unsigned f2bf(float f) { unsigned u = __builtin_bit_cast(unsigned, f); return (u + 0x7fffu + ((u >> 16) & 1u)) >> 16; }
__device__ __forceinline__ unsigned pk2(float lo, float hi) { return f2bf(lo) | (f2bf(hi) << 16); }

#define XB_TMO      128
#define XB_XCNT(j)  (256  + 64 * (j))
#define XB_XSUB(j)  (1280 + 64 * (j))
#define XB_XGEN(j)  (2304 + 64 * (j))
#define XB_TOP      3328
#define XB_TOPGEN   3392
#define XCD_BAR_WORDS 3456
#define XB_SPIN_CAP (1u << 18)

__device__ __forceinline__ unsigned xb_ld(unsigned* p)              { return __hip_atomic_load(p, __ATOMIC_RELAXED, __HIP_MEMORY_SCOPE_AGENT); }
__device__ __forceinline__ unsigned xb_add(unsigned* p, unsigned v) { return __hip_atomic_fetch_add(p, v, __ATOMIC_RELAXED, __HIP_MEMORY_SCOPE_AGENT); }
__device__ __forceinline__ unsigned xb_xcc_id() { return (unsigned)__builtin_amdgcn_s_getreg((3 << 11) | 20) & 0xFu; }
#define XB_SPIN(cond, bar) do { unsigned _sp = 0; while (cond) { __builtin_amdgcn_s_sleep(1); \
    if ((++_sp & 255u) == 0u) { if (xb_ld(&(bar)[XB_TMO])) break; if (_sp > XB_SPIN_CAP) { atomicAdd(&(bar)[XB_TMO], 1u); break; } } } } while (0)

struct XcdBarrier {
    unsigned* bar; unsigned x;
    volatile LAS unsigned* st;
};

__device__ __forceinline__ XcdBarrier xcd_barrier_post(unsigned* bar, volatile LAS unsigned* st) {
    XcdBarrier b; b.bar = bar; b.x = xb_xcc_id(); b.st = st;
    if (threadIdx.x == 0) (void)xb_add(&bar[XB_XCNT(b.x)], 1u);
    return b;
}
__device__ __forceinline__ void xcd_barrier_complete(unsigned* bar, unsigned x, unsigned& nloc, unsigned& nx) {
    const unsigned G = gridDim.x * gridDim.y * gridDim.z;
    unsigned sum, cnt, mine, sp = 0u;
    for (;;) {
        sum = 0u; cnt = 0u; mine = 0u;
#pragma unroll
        for (unsigned j = 0; j < 16; ++j) { const unsigned c = xb_ld(&bar[XB_XCNT(j)]); sum += c; cnt += (c > 0u) ? 1u : 0u; mine = (j == x) ? c : mine; }
        if (sum == G) break;
        __builtin_amdgcn_s_sleep(1);
        if ((++sp & 255u) == 0u) { if (xb_ld(&bar[XB_TMO])) break; if (sp > XB_SPIN_CAP) { atomicAdd(&bar[XB_TMO], 1u); break; } }
    }
    nloc = mine > 0u ? mine : 1u; nx = cnt > 0u ? cnt : 1u;
}

__device__ __forceinline__ void xcd_barrier(const XcdBarrier& b) {
    asm volatile("s_waitcnt vmcnt(0)" ::: "memory");
    __syncthreads();
    if (threadIdx.x == 0) {
        unsigned* bar = b.bar;
        __builtin_amdgcn_s_waitcnt(0);
        unsigned nloc = b.st[0], nx = b.st[1];
        if (nloc == 0u) { xcd_barrier_complete(bar, b.x, nloc, nx); b.st[0] = nloc; b.st[1] = nx; }
        const unsigned old = xb_add(&bar[XB_XSUB(b.x)], 1u);
        const unsigned gen = old / nloc;
        if (old + 1u == (gen + 1u) * nloc) {
            __builtin_amdgcn_fence(__ATOMIC_RELEASE, "agent");
            asm volatile("s_waitcnt vmcnt(0)" ::: "memory");
            const unsigned og = xb_add(&bar[XB_TOP], 1u);
            const unsigned tg = og / nx;
            if (og + 1u == (tg + 1u) * nx) xb_add(&bar[XB_TOPGEN], 1u);
            else XB_SPIN(xb_ld(&bar[XB_TOPGEN]) == tg, bar);
            __builtin_amdgcn_fence(__ATOMIC_ACQUIRE, "agent");
            xb_add(&bar[XB_XGEN(b.x)], 1u);
            asm volatile("s_waitcnt vmcnt(0)" ::: "memory");
        } else {
            XB_SPIN(xb_ld(&bar[XB_XGEN(b.x)]) == gen, bar);
            __builtin_amdgcn_fence(__ATOMIC_ACQUIRE, "agent");
            asm volatile("s_waitcnt vmcnt(0)" ::: "memory");
        }
    }
    __syncthreads();
}

constexpr int NB = 8, SEQ = 4096, TOK = NB * SEQ, DM = 1024, FF = 4096, DEPTH = 2;
constexpr int IN_W = 7240;
constexpr int NQKV = 4352;
constexpr int NGATE = 3072, KMERGE = 1152;
constexpr int NWAVES = 8;
#ifndef MK_ONE_LAUNCH
#define MK_ONE_LAUNCH 1
#endif
#ifndef REPEAT_PHASE
#define REPEAT_PHASE 0
#endif
#define REP(k, ...) do { __VA_ARGS__ if (REPEAT_PHASE == (k)) { __VA_ARGS__ } } while (0)
#ifndef PRIO_LVL
#define PRIO_LVL 1
#endif
constexpr int N_PHASES = 19;

constexpr size_t MiB = 1u << 20;
constexpr size_t WS_CTL = 0, CTL_ZERO_BYTES = 1 * MiB;
constexpr size_t WS_WQKV = 1 * MiB;
constexpr size_t WS_WG   = WS_WQKV + (size_t)NQKV * DM * 2;
constexpr size_t WS_WM   = WS_WG + (size_t)NGATE * DM * 2;
constexpr size_t WS_WO   = WS_WM + (size_t)DM * KMERGE * 2;
constexpr size_t WS_WUP  = WS_WO + (size_t)DM * DM * 2;
constexpr size_t WS_WDN  = WS_WUP + (size_t)FF * DM * 2;
constexpr size_t WS_HB   = 36 * MiB;
constexpr size_t WS_SSQ  = 100 * MiB;
constexpr size_t WS_CS   = 102 * MiB;
constexpr size_t WS_O    = 110 * MiB;
constexpr size_t WS_OG   = 182 * MiB;
constexpr size_t WS_LSE  = 230 * MiB;
constexpr size_t WS_ZA   = 232 * MiB;
constexpr size_t WS_AQ = WS_ZA, WS_AK = WS_AQ + 24 * MiB, WS_AV = WS_AK + 4 * MiB, WS_IQ = WS_AV + 4 * MiB, WS_IK = WS_IQ + 32 * MiB, WS_IW = WS_IK + 4 * MiB;
constexpr size_t WS_ZBC  = 302 * MiB;
constexpr size_t WS_BQ = WS_ZBC, WS_BK = WS_BQ + 48 * MiB, WS_BV = WS_BK + 48 * MiB, WS_CQ = WS_BV + 48 * MiB, WS_CK = WS_CQ + 32 * MiB, WS_CV = WS_CK + 8 * MiB;
constexpr size_t WS_END  = 494 * MiB;
constexpr size_t WS_GATES = WS_ZBC;
constexpr size_t WS_MERGED = WS_ZA;
constexpr size_t WS_HID = WS_ZA;
static_assert(WS_WDN + (size_t)DM * FF * 2 <= WS_HB && WS_IW + (size_t)TOK * 8 * 4 <= WS_ZBC && WS_CV + 8 * MiB == WS_END && WS_HID + (size_t)TOK * FF * 2 <= WS_END, "d_ws map");
constexpr int CW_BAR = 4096;

constexpr int RING_BYTES = 131072;
constexpr int LDSCTL_OFF = RING_BYTES, MISC_OFF = LDSCTL_OFF + 320;
constexpr int LDS_BYTES = 147456;

typedef float f32x16 __attribute__((ext_vector_type(16)));
typedef float f32x2 __attribute__((ext_vector_type(2)));
typedef _Float16 f16x8 __attribute__((ext_vector_type(8)));
typedef short s16x4 __attribute__((ext_vector_type(4)));
typedef short v4i16_t __attribute__((ext_vector_type(4)));
typedef unsigned u32x2 __attribute__((ext_vector_type(2)));
#define DI __device__ __forceinline__
using pg8::pkbf; using pg8::bflo; using pg8::bfhi; using pg8::u32x4; using pg8::bf16_t;

DI int crow(int i, int h) { return (i & 3) + 8 * (i >> 2) + 4 * h; }
DI float wave_sum(float v) {
#pragma unroll
    for (int o = 1; o < 64; o <<= 1) v += __shfl_xor(v, o);
    return v;
}
DI s16x4 vtr(const LAS char* p) { return __builtin_bit_cast(s16x4, __builtin_amdgcn_ds_read_tr16_b64_v4i16((LAS v4i16_t*)p)); }

struct OState { f32x16 o0, o1; float m, l; };

DI float xhalf_max(float v) { auto rr = __builtin_amdgcn_permlane32_swap(__float_as_uint(v), __float_as_uint(v), false, false); return fmaxf(__uint_as_float(rr[0]), __uint_as_float(rr[1])); }
DI float xhalf_sum(float v) { auto rr = __builtin_amdgcn_permlane32_swap(__float_as_uint(v), __float_as_uint(v), false, false); return __uint_as_float(rr[0]) + __uint_as_float(rr[1]); }
DI void softmax_pv(OState& S, f32x16 s, const LAS char* vbuf, int lane) {
    const float m0 = fmaxf(fmaxf(s[0], s[1]), fmaxf(s[2], s[3])), m1 = fmaxf(fmaxf(s[4], s[5]), fmaxf(s[6], s[7]));
    const float m2 = fmaxf(fmaxf(s[8], s[9]), fmaxf(s[10], s[11])), m3 = fmaxf(fmaxf(s[12], s[13]), fmaxf(s[14], s[15]));
    const float mx = xhalf_max(fmaxf(fmaxf(m0, m1), fmaxf(m2, m3)));
    const float mnew = fmaxf(S.m, mx);
    const float msafe = (mnew == -INFINITY) ? 0.f : mnew;
    const float alpha = __builtin_amdgcn_exp2f(S.m - msafe);
    float p[16];
#pragma unroll
    for (int i = 0; i < 16; ++i) p[i] = __builtin_amdgcn_exp2f(s[i] - msafe);
    const float ls = ((p[0] + p[1]) + (p[2] + p[3])) + ((p[4] + p[5]) + (p[6] + p[7])) + (((p[8] + p[9]) + (p[10] + p[11])) + ((p[12] + p[13]) + (p[14] + p[15])));
    S.l = S.l * alpha + ls; S.m = mnew;
    S.o0 = S.o0 * alpha; S.o1 = S.o1 * alpha;
    u32x4 w0, w1;
    w0.x = pkbf(p[0], p[1]); w0.y = pkbf(p[2], p[3]); w0.z = pkbf(p[4], p[5]); w0.w = pkbf(p[6], p[7]);
    w1.x = pkbf(p[8], p[9]); w1.y = pkbf(p[10], p[11]); w1.z = pkbf(p[12], p[13]); w1.w = pkbf(p[14], p[15]);
    const bf16x8 pb0 = __builtin_bit_cast(bf16x8, w0), pb1 = __builtin_bit_cast(bf16x8, w1);
    const int h = lane >> 5, i16 = lane & 15, q = i16 >> 2, pp = i16 & 3, g16 = (lane >> 4) & 1;
    const LAS char* vb = vbuf + (4 * h + q) * 128 + (16 * g16 + 4 * pp) * 2;
#pragma unroll
    for (int dt = 0; dt < 2; ++dt) {
        const s16x4 lo0 = vtr(vb + dt * 64), hi0 = vtr(vb + dt * 64 + 8 * 128), lo1 = vtr(vb + dt * 64 + 16 * 128), hi1 = vtr(vb + dt * 64 + 24 * 128);
        const bf16x8 va0 = __builtin_shufflevector(lo0, hi0, 0, 1, 2, 3, 4, 5, 6, 7), va1 = __builtin_shufflevector(lo1, hi1, 0, 1, 2, 3, 4, 5, 6, 7);
        if (dt == 0) { S.o0 = __builtin_amdgcn_mfma_f32_32x32x16_bf16(va0, pb0, S.o0, 0, 0, 0); S.o0 = __builtin_amdgcn_mfma_f32_32x32x16_bf16(va1, pb1, S.o0, 0, 0, 0); }
        else         { S.o1 = __builtin_amdgcn_mfma_f32_32x32x16_bf16(va0, pb0, S.o1, 0, 0, 0); S.o1 = __builtin_amdgcn_mfma_f32_32x32x16_bf16(va1, pb1, S.o1, 0, 0, 0); }
    }
}

DI f32x16 zero16() { f32x16 z;
#pragma unroll
    for (int i = 0; i < 16; ++i) z[i] = 0.f;
    return z; }

DI void store_ot(const OState& S, bf16_t* orow, int h) {
    const float inv = 1.0f / xhalf_sum(S.l);
#pragma unroll
    for (int g = 0; g < 4; ++g) {
        u32x2 w0, w1;
        w0.x = pkbf(S.o0[4 * g] * inv, S.o0[4 * g + 1] * inv); w0.y = pkbf(S.o0[4 * g + 2] * inv, S.o0[4 * g + 3] * inv);
        w1.x = pkbf(S.o1[4 * g] * inv, S.o1[4 * g + 1] * inv); w1.y = pkbf(S.o1[4 * g + 2] * inv, S.o1[4 * g + 3] * inv);
        *(u32x2*)(orow + 8 * g + 4 * h) = w0; *(u32x2*)(orow + 32 + 8 * g + 4 * h) = w1;
    }
}

struct Ptrs {
    const float* x; const int* pos; const float *attn_norm, *w_in, *iknorm, *sinks, *w_a, *w_b, *w_c, *w_o, *mlp_norm, *w_up, *w_down, *final_norm;
    float* out; unsigned char* ws;
};

struct GDesc { const char* K; const char* V; const char* Q0; bf16_t* out; float* lse; int pq, pkv, po, tb, d, r0, i0g, W, ntile, typeC, head0; };
DI GDesc bc_gdesc(const Ptrs& P, int t) {
    GDesc D; const int b = t & 7; D.tb = b * SEQ;
    if (t < 1536) {
        const int rest = t >> 3, head = rest >> 4, grp = rest & 15, g = head >> 2, j = head & 3;
        D.d = (g == 0) ? 1 : (g == 1 ? 4 : 16);
        const int gpc = 16 / D.d;
        D.r0 = grp / gpc; D.i0g = 256 * (grp % gpc); D.W = 129; D.ntile = 12; D.typeC = 0; D.head0 = head;
        D.K = (const char*)((const bf16_t*)(P.ws + WS_BK) + head * 64); D.V = (const char*)((const bf16_t*)(P.ws + WS_BV) + head * 64); D.Q0 = (const char*)((const bf16_t*)(P.ws + WS_BQ) + head * 64);
        D.pq = 768 * 2; D.pkv = 768 * 2; D.po = 256;
        D.out = (bf16_t*)(P.ws + WS_OG) + (size_t)g * TOK * 256 + j * 64; D.lse = (float*)(P.ws + WS_LSE) + (size_t)g * TOK * 4 + j;
    } else {
        const int c = t - 1536, rest = c >> 3, kvh = rest >> 6, grp = rest & 63;
        D.d = 1; D.r0 = 0; D.i0g = 64 * grp; D.W = 128; D.ntile = 6; D.typeC = 1; D.head0 = 4 * kvh;
        D.K = (const char*)((const bf16_t*)(P.ws + WS_CK) + kvh * 64); D.V = (const char*)((const bf16_t*)(P.ws + WS_CV) + kvh * 64); D.Q0 = (const char*)((const bf16_t*)(P.ws + WS_CQ) + 4 * kvh * 64);
        D.pq = 512 * 2; D.pkv = 128 * 2; D.po = KMERGE;
        D.out = (bf16_t*)(P.ws + WS_O) + 640 + 4 * kvh * 64; D.lse = nullptr;
    }
    return D;
}
DI void attn_bc_phase2(const Ptrs& P, int layer, LAS unsigned char* lds, int wave, int lane) {
    const int G = gridDim.x, w = blockIdx.x;
    const int r = lane & 31, h = lane >> 5, tid = wave * 64 + lane;
    LAS char* kimg = (LAS char*)lds; LAS char* vimg = kimg + 49152;
    unsigned mlo129 = 0u, mlo128 = 0u, mhi = 0u;
#pragma unroll
    for (int i = 0; i < 16; ++i) { const int c = crow(i, h); mlo129 |= (c >= r) ? (1u << i) : 0u; mlo128 |= (c > r) ? (1u << i) : 0u; mhi |= (c <= r) ? (1u << i) : 0u; }
    auto img_ld = [&](u32x4 (&st)[12], const GDesc& D) {
        const int np = D.ntile * 32 * 8;
#pragma unroll
        for (int i = 0; i < 12; ++i) {
            const int p = tid + 512 * i;
            if (p < 2 * np) {
                const int isV = p >= np ? 1 : 0, q = p - isV * np, row = q >> 3, ch = q & 7;
                int cls = D.i0g - 128 + row; cls = cls < 0 ? 0 : cls;
                st[i] = *(const u32x4*)((isV ? D.V : D.K) + (size_t)(unsigned)((D.tb + D.r0 + D.d * cls) * D.pkv + 16 * ch));
            }
        }
    };
    auto img_st = [&](const u32x4 (&st)[12], const GDesc& D) {
        const int np = D.ntile * 32 * 8;
#pragma unroll
        for (int i = 0; i < 12; ++i) {
            const int p = tid + 512 * i;
            if (p < 2 * np) {
                const int isV = p >= np ? 1 : 0, q = p - isV * np, row = q >> 3, ch = q & 7;
                if (isV) *(LAS u32x4*)(vimg + row * 128 + 16 * ch) = st[i]; else *(LAS u32x4*)(kimg + row * 128 + 16 * (ch ^ (row & 7))) = st[i];
            }
        }
    };
    auto q_ld = [&](bf16x8 (&q)[4], const GDesc& D) {
        const int jq = D.typeC ? (wave & 1) : wave, hl = D.typeC ? (wave >> 1) : 0;
        const char* qr = D.Q0 + hl * 128 + (size_t)(D.tb + D.r0 + D.d * (D.i0g + 32 * jq + r)) * D.pq + 16 * h;
#pragma unroll
        for (int s = 0; s < 4; ++s) q[s] = *(const bf16x8*)(qr + 32 * s); };
    int t = w; const int tstride = G;
    if (t >= 2560) return;
    u32x4 stg[12]; bf16x8 qn[4];
    GDesc D = bc_gdesc(P, t);
    img_ld(stg, D); q_ld(qn, D);
#pragma unroll 1
    for (; t < 2560; t += tstride) {
        img_st(stg, D);
        bf16x8 qf[4];
#pragma unroll
        for (int s = 0; s < 4; ++s) qf[s] = qn[s];
        __syncthreads();
        const bool more = (t + tstride) < 2560;
        const GDesc N = bc_gdesc(P, more ? t + tstride : t);
        img_ld(stg, N); q_ld(qn, N);
        const int jq = D.typeC ? (wave & 1) : wave, hl = D.typeC ? (wave >> 1) : 0;
        OState S; S.o0 = zero16(); S.o1 = zero16();
        S.m = D.typeC ? P.sinks[layer * 8 + D.head0 + hl] * 1.4426950408889634f : -INFINITY; S.l = (D.typeC && h == 0) ? 1.f : 0.f;
        const unsigned mlo = (D.W == 129) ? mlo129 : mlo128;
        const int i0 = D.i0g + 32 * jq;
#pragma unroll
        for (int kt = 0; kt < 5; ++kt) {
            if (i0 - 128 + 32 * kt >= 0) {
                const LAS char* kb = kimg + (32 * (jq + kt)) * 128; const LAS char* vb = vimg + (32 * (jq + kt)) * 128;
                f32x16 st = zero16();
#pragma unroll
                for (int s = 0; s < 4; ++s) { const bf16x8 kf = *(const LAS bf16x8*)(kb + r * 128 + 16 * ((2 * s + h) ^ (r & 7))); st = __builtin_amdgcn_mfma_f32_32x32x16_bf16(kf, qf[s], st, 0, 0, 0); }
                if (kt == 0 || kt == 4) {
                    const unsigned mk = (kt == 0) ? mlo : mhi;
#pragma unroll
                    for (int i = 0; i < 16; ++i) st[i] = ((mk >> i) & 1u) ? st[i] : -INFINITY;
                }
                softmax_pv(S, st, vb, lane);
            }
        }
        const int tq = D.tb + D.r0 + D.d * (i0 + r);
        store_ot(S, D.out + hl * 64 + (size_t)tq * D.po, h);
        { const float lt = xhalf_sum(S.l); if (D.lse && h == 0) D.lse[(size_t)tq * 4] = S.m + __builtin_amdgcn_logf(lt); }
        __syncthreads();
        D = N;
    }
}

DI void bmerge_rows(const Ptrs& P, int wave, int lane) {
    const int G = gridDim.x;
    const bf16_t* og = (const bf16_t*)(P.ws + WS_OG); const float* lse = (const float*)(P.ws + WS_LSE); bf16_t* O = (bf16_t*)(P.ws + WS_O);
    const int j = lane >> 4, e = 4 * (lane & 15), NGW = G * NWAVES;
    int t = blockIdx.x * NWAVES + wave;
    if (t >= TOK) return;
    float ln[3]; u32x2 vn[3];
#pragma unroll
    for (int g = 0; g < 3; ++g) { ln[g] = lse[((size_t)g * TOK + t) * 4 + j]; vn[g] = *(const u32x2*)(og + ((size_t)g * TOK + t) * 256 + j * 64 + e); }
    for (; t < TOK; t += NGW) {
        const float l0 = ln[0], l1 = ln[1], l2 = ln[2]; const u32x2 v0 = vn[0], v1 = vn[1], v2 = vn[2];
        { const int tn = (t + NGW < TOK) ? t + NGW : t;
#pragma unroll
          for (int g = 0; g < 3; ++g) { ln[g] = lse[((size_t)g * TOK + tn) * 4 + j]; vn[g] = *(const u32x2*)(og + ((size_t)g * TOK + tn) * 256 + j * 64 + e); } }
        const float mx = fmaxf(l0, fmaxf(l1, l2));
        float a0 = __builtin_amdgcn_exp2f(l0 - mx), a1 = __builtin_amdgcn_exp2f(l1 - mx), a2 = __builtin_amdgcn_exp2f(l2 - mx);
        const float inv = 1.0f / (a0 + a1 + a2); a0 *= inv; a1 *= inv; a2 *= inv;
        u32x2 o;
        o.x = pkbf(a0 * bflo(v0.x) + a1 * bflo(v1.x) + a2 * bflo(v2.x), a0 * bfhi(v0.x) + a1 * bfhi(v1.x) + a2 * bfhi(v2.x));
        o.y = pkbf(a0 * bflo(v0.y) + a1 * bflo(v1.y) + a2 * bflo(v2.y), a0 * bfhi(v0.y) + a1 * bfhi(v1.y) + a2 * bfhi(v2.y));
        *(u32x2*)(O + (size_t)t * KMERGE + 384 + j * 64 + e) = o;
    }
}

DI float relu_i(float x) { const int xi = __builtin_bit_cast(int, x); return __builtin_bit_cast(float, xi > 0 ? xi : 0); }
DI unsigned mono_key(float f) { const unsigned u = __builtin_bit_cast(unsigned, f); return u ^ ((unsigned)((int)u >> 31) | 0x80000000u); }
DI unsigned lane_lt_count(unsigned long long m) { return __builtin_amdgcn_mbcnt_hi((unsigned)(m >> 32), __builtin_amdgcn_mbcnt_lo((unsigned)m, 0u)); }

DI unsigned wave_prefix_incl(unsigned v) {
    v += (unsigned)__builtin_amdgcn_update_dpp(0, (int)v, 0x111, 0xf, 0xf, true);
    v += (unsigned)__builtin_amdgcn_update_dpp(0, (int)v, 0x112, 0xf, 0xf, true);
    v += (unsigned)__builtin_amdgcn_update_dpp(0, (int)v, 0x114, 0xf, 0xf, true);
    v += (unsigned)__builtin_amdgcn_update_dpp(0, (int)v, 0x118, 0xf, 0xf, true);
    v += (unsigned)__builtin_amdgcn_update_dpp(0, (int)v, 0x142, 0xa, 0xf, true);
    v += (unsigned)__builtin_amdgcn_update_dpp(0, (int)v, 0x143, 0xc, 0xf, true);
    return v;
}
template <int LOGB> DI void hist_find(const LAS unsigned* hist, unsigned need, int lane, unsigned& B, unsigned& above, unsigned& cB) {
    constexpr int PER = (1 << LOGB) / 64;
    unsigned s = 0;
#pragma unroll
    for (int b = 0; b < PER; ++b) s += hist[lane * PER + ((b + lane) & (PER - 1))];
    const unsigned pre = wave_prefix_incl(s);
    const unsigned tot = (unsigned)__builtin_amdgcn_readlane((int)pre, 63);
    const unsigned suf = tot - pre + s;
    const unsigned long long mk = __ballot(suf >= need);
    const int Lc = 63 - __builtin_clzll(mk | 1ull);
    const unsigned run0 = (unsigned)__builtin_amdgcn_readlane((int)suf, Lc) - (unsigned)__builtin_amdgcn_readlane((int)s, Lc);
    const unsigned cb = (lane < PER) ? hist[Lc * PER + lane] : 0u;
    const unsigned pre2 = wave_prefix_incl(cb);
    const unsigned tot2 = (unsigned)__builtin_amdgcn_readlane((int)pre2, 63);
    const unsigned suf2 = tot2 - pre2 + cb;
    const unsigned long long mk2 = __ballot((lane < PER) && (run0 + suf2 >= need));
    const int bc = 63 - __builtin_clzll(mk2 | 1ull);
    B = (unsigned)(Lc * PER + bc); cB = (unsigned)__builtin_amdgcn_readlane((int)cb, bc); above = run0 + (unsigned)__builtin_amdgcn_readlane((int)suf2, bc) - cB;
}
template <int LOGB> DI void hist_zero(LAS unsigned* hist, int lane) {
    constexpr int N4 = (1 << LOGB) / 4 / 64;
#pragma unroll
    for (int i = 0; i < N4; ++i) ((LAS u32x4*)hist)[i * 64 + lane] = (u32x4){0u, 0u, 0u, 0u};
}

DI void select_top256(const float* row, int n, LAS unsigned* hist, LAS unsigned short* idx, int lane) {
    unsigned key[16][4];
    {
        f32x4 v[16];
        const int jmax = (n - 1) >> 8;
#pragma unroll
        for (int j = 0; j < 16; ++j) v[j] = *(const f32x4*)(row + 256 * (j <= jmax ? j : 0) + 4 * lane);
#pragma unroll
        for (int j = 0; j < 16; ++j)
#pragma unroll
            for (int c = 0; c < 4; ++c) key[j][c] = (256 * j + 4 * lane + c < n) ? mono_key(v[j][c]) : 0u;
    }
    unsigned B1, ab1, c1;
    hist_zero<11>(hist, lane);
#pragma unroll
    for (int j = 0; j < 16; ++j) if (256 * j < n) {
#pragma unroll
        for (int c = 0; c < 4; ++c) __hip_atomic_fetch_add(hist + (key[j][c] >> 21), 1u, __ATOMIC_RELAXED, __HIP_MEMORY_SCOPE_WAVEFRONT);
    }
    hist_find<11>(hist, 256u, lane, B1, ab1, c1);
    unsigned need = 256u - ab1;
    unsigned kgt, kstar = 0u, quota = 0u;
    if (c1 == need) { kgt = (B1 << 21) - 1u; }
    else {
        unsigned B2, ab2, c2;
        hist_zero<11>(hist, lane);
#pragma unroll
        for (int j = 0; j < 16; ++j) if (256 * j < n) {
#pragma unroll
            for (int c = 0; c < 4; ++c) { const unsigned k = key[j][c]; if ((k >> 21) == B1) __hip_atomic_fetch_add(hist + ((k >> 10) & 0x7ffu), 1u, __ATOMIC_RELAXED, __HIP_MEMORY_SCOPE_WAVEFRONT); }
        }
        hist_find<11>(hist, need, lane, B2, ab2, c2);
        need -= ab2;
        const unsigned pre = (B1 << 11) | B2;
        if (c2 == need) { kgt = (pre << 10) - 1u; }
        else {
            unsigned B3, ab3, c3;
            hist_zero<10>(hist, lane);
#pragma unroll
            for (int j = 0; j < 16; ++j) if (256 * j < n) {
#pragma unroll
                for (int c = 0; c < 4; ++c) { const unsigned k = key[j][c]; if ((k >> 10) == pre) __hip_atomic_fetch_add(hist + (k & 0x3ffu), 1u, __ATOMIC_RELAXED, __HIP_MEMORY_SCOPE_WAVEFRONT); }
            }
            hist_find<10>(hist, need, lane, B3, ab3, c3);
            need -= ab3;
            kstar = (pre << 10) | B3; kgt = kstar; quota = need;
        }
    }
    unsigned selm[16];
    unsigned eqn = 0, mycnt = 0;
#pragma unroll
    for (int j = 0; j < 16; ++j) {
        unsigned nib = 0u;
        if (256 * j < n) {
            if (quota != 0u) {
                bool eq[4]; unsigned below = 0u, tot = 0u;
#pragma unroll
                for (int c = 0; c < 4; ++c) { eq[c] = key[j][c] == kstar; const unsigned long long em = __ballot(eq[c]); below += lane_lt_count(em); tot += (unsigned)__builtin_popcountll(em); }
                unsigned run = eqn + below;
#pragma unroll
                for (int c = 0; c < 4; ++c) { const bool s = (key[j][c] > kgt) || (eq[c] && run < quota); run += eq[c] ? 1u : 0u; nib |= s ? (1u << c) : 0u; }
                eqn += tot;
            } else {
#pragma unroll
                for (int c = 0; c < 4; ++c) nib |= (key[j][c] > kgt) ? (1u << c) : 0u;
            }
        }
        selm[j] = nib; mycnt += (unsigned)__builtin_popcount(nib);
    }
    const unsigned pre = wave_prefix_incl(mycnt);
    unsigned pos = pre - mycnt;
    unsigned mlo = 0u, mhi = 0u;
#pragma unroll
    for (int j = 0; j < 8; ++j) { mlo |= selm[j] << (4 * j); mhi |= selm[8 + j] << (4 * j); }
    while (mlo | mhi) {
        unsigned e;
        if (mlo) { const unsigned bpos = (unsigned)__builtin_ctz(mlo); mlo &= mlo - 1u; e = ((bpos >> 2) << 8) + (bpos & 3u); }
        else     { const unsigned bpos = (unsigned)__builtin_ctz(mhi); mhi &= mhi - 1u; e = (((bpos >> 2) + 8u) << 8) + (bpos & 3u); }
        if (pos < 256u) idx[pos] = (unsigned short)(e + 4u * (unsigned)lane);
        ++pos;
    }
}

DI void dsa_rows(const Ptrs& P, int b, int qb, float* slab, LAS unsigned char* lds, int wave, int lane);
DI void dsa_unit(const Ptrs& P, int b, int qb, float* slab, LAS unsigned char* lds, int wave, int lane_) {
    const int lane = pg8::opaque_lane(); (void)lane_;
    const int r = lane & 31, h = lane >> 5, t0 = 32 * qb, tb = b * SEQ;
    {
        const _Float16* IQ = (const _Float16*)(P.ws + WS_IQ) + (size_t)(tb + t0 + r) * 512;
        const _Float16* IK = (const _Float16*)(P.ws + WS_IK) + (size_t)tb * 64;
        const float* IW = (const float*)(P.ws + WS_IW) + (size_t)(tb + t0 + r) * 8;
        LAS f16x8* QF = (LAS f16x8*)(lds + 81920);
#pragma unroll
        for (int s = 0; s < 4; ++s) QF[(wave * 4 + s) * 64 + lane] = *(const f16x8*)(IQ + wave * 64 + 16 * s + 8 * h);
        const f32x4 w03 = *(const f32x4*)IW, w47 = *(const f32x4*)(IW + 4);
        const float wv[8] = {w03.x, w03.y, w03.z, w03.w, w47.x, w47.y, w47.z, w47.w};
        __syncthreads();
        f16x8 kfn[4];
        { const _Float16* kr0 = IK + (size_t)(32 * (wave <= qb ? wave : qb) + r) * 64 + 8 * h;
#pragma unroll
          for (int s = 0; s < 4; ++s) kfn[s] = *(const f16x8*)(kr0 + 16 * s); }
#ifdef SCORE_STAGGER
        if (wave >= 4) { const unsigned long long t0s = __builtin_amdgcn_s_memrealtime(); while (__builtin_amdgcn_s_memrealtime() - t0s < SCORE_STAGGER) __builtin_amdgcn_s_sleep(2); }
#endif
#pragma unroll 1
        for (int kt = wave; kt <= qb; kt += NWAVES) {
            asm volatile("" ::: "memory");
            f16x8 kf[4];
#pragma unroll
            for (int s = 0; s < 4; ++s) kf[s] = kfn[s];
            { const int kn = (kt + NWAVES <= qb) ? kt + NWAVES : qb; const _Float16* kr = IK + (size_t)(32 * kn + r) * 64 + 8 * h;
#pragma unroll
              for (int s = 0; s < 4; ++s) kfn[s] = *(const f16x8*)(kr + 16 * s); }
            f32x16 sc = zero16();
            f16x8 qa[4], qb2[4];
#pragma unroll
            for (int s = 0; s < 4; ++s) { qa[s] = QF[s * 64 + lane]; qb2[s] = QF[(4 + s) * 64 + lane]; }
            f32x16 accA = zero16(), accB = zero16();
#pragma unroll
            for (int s = 0; s < 4; ++s) accA = __builtin_amdgcn_mfma_f32_32x32x16_f16(kf[s], qa[s], accA, 0, 0, 0);
            __builtin_amdgcn_sched_barrier(0);
#pragma unroll
            for (int hd = 0; hd < 8; ++hd) {
                if (hd < 7) {
                    if ((hd & 1) == 0) {
#pragma unroll
                        for (int s = 0; s < 4; ++s) accB = __builtin_amdgcn_mfma_f32_32x32x16_f16(kf[s], qb2[s], s == 0 ? zero16() : accB, 0, 0, 0);
                        if (hd < 6) {
#pragma unroll
                            for (int s = 0; s < 4; ++s) qa[s] = QF[((hd + 2) * 4 + s) * 64 + lane];
                        }
                    } else {
#pragma unroll
                        for (int s = 0; s < 4; ++s) accA = __builtin_amdgcn_mfma_f32_32x32x16_f16(kf[s], qa[s], s == 0 ? zero16() : accA, 0, 0, 0);
                        if (hd < 6) {
#pragma unroll
                            for (int s = 0; s < 4; ++s) qb2[s] = QF[((hd + 2) * 4 + s) * 64 + lane];
                        }
                    }
                }
                if ((hd & 1) == 0) {
#pragma unroll
                    for (int i = 0; i < 16; ++i) sc[i] = fmaf(wv[hd], relu_i(accA[i]), sc[i]);
                } else {
#pragma unroll
                    for (int i = 0; i < 16; ++i) sc[i] = fmaf(wv[hd], relu_i(accB[i]), sc[i]);
                }
                __builtin_amdgcn_sched_barrier(0);
            }
            float* o = slab + (size_t)r * 4096 + 32 * kt + 4 * h;
#pragma unroll
            for (int g = 0; g < 4; ++g) *(f32x4*)(o + 8 * g) = (f32x4){sc[4 * g], sc[4 * g + 1], sc[4 * g + 2], sc[4 * g + 3]};
        }
    }
    __syncthreads();
    SUBT(1, lds);
    const int lane2_ = pg8::opaque_lane();
    dsa_rows(P, b, qb, slab, lds, wave, lane2_);
    __syncthreads();
    SUBT(3, lds);
}

typedef float f32x4v __attribute__((ext_vector_type(4)));
DI float xrow_max(float v) {
    auto r1 = __builtin_amdgcn_permlane16_swap(__float_as_uint(v), __float_as_uint(v), false, false);
    return xhalf_max(fmaxf(__uint_as_float(r1[0]), __uint_as_float(r1[1])));
}
DI float xrow_sum(float v) {
    auto r1 = __builtin_amdgcn_permlane16_swap(__float_as_uint(v), __float_as_uint(v), false, false);
    return xhalf_sum(__uint_as_float(r1[0]) + __uint_as_float(r1[1]));
}
DI void dsa_rows(const Ptrs& P, int b, int qb, float* slab, LAS unsigned char* lds, int wave, int lane) {
    const int t0 = 32 * qb, tb = b * SEQ;
    LAS unsigned* hist = (LAS unsigned*)(lds + wave * 8192);
    LAS char* kbuf = (LAS char*)(lds + wave * 8192); LAS char* vbuf = kbuf + 4096;
    LAS char* qrows = (LAS char*)(lds + 81920 + wave * 3072);
    LAS int* cntp = (LAS int*)(lds + 81920 + 24576 + wave * 16);
    const bf16_t* AQ = (const bf16_t*)(P.ws + WS_AQ); const bf16_t* AK = (const bf16_t*)(P.ws + WS_AK) + (size_t)tb * 64; const bf16_t* AV = (const bf16_t*)(P.ws + WS_AV) + (size_t)tb * 64;
    u32x4 qst[4];
#pragma unroll
    for (int qq = 0; qq < 4; ++qq) qst[qq] = (lane < 48) ? *(const u32x4*)((const char*)(AQ + (size_t)(tb + t0 + wave + 8 * qq) * 384) + lane * 16) : (u32x4){0u, 0u, 0u, 0u};
#pragma unroll 1
    for (int qq = 0; qq < 4; ++qq) {
        const int q = wave + 8 * qq, t = t0 + q, n = t + 1;
        LAS unsigned short* idx = (LAS unsigned short*)(lds + 65536 + q * 512);
        int c;
        if (n <= 256) { for (int i = lane; i < n; i += 64) idx[i] = (unsigned short)i; c = n; }
        else { select_top256(slab + (size_t)q * 4096, n, hist, idx, lane); c = 256; }
        if (lane == 0) cntp[qq] = c;
    }
#pragma unroll
    for (int qq = 0; qq < 4; ++qq) if (lane < 48) *(LAS u32x4*)(qrows + qq * 768 + lane * 16) = qst[qq];
    SUBT(2, lds);
    const int c16 = lane & 15, g4 = lane >> 4, l8 = lane >> 3, c8 = lane & 7;
    u32x4 ks[4][4], vs[2][4];
    auto key_of = [&](int qq, int kt, int i) -> int {
        const int qe = qq < 4 ? qq : 3;
        const int cf = __builtin_amdgcn_readfirstlane(cntp[qe]);
        const int slot = 32 * kt + 8 * i + l8;
        const LAS unsigned short* idx = (const LAS unsigned short*)(lds + 65536 + (wave + 8 * qe) * 512);
        return (qq < 4 && slot < cf) ? (int)idx[slot] : 0;
    };
    auto fetch_k = [&](u32x4 (&k)[4], int qq, int kt) {
#pragma unroll
        for (int i = 0; i < 4; ++i) k[i] = *(const u32x4*)((const char*)AK + (size_t)(unsigned)(key_of(qq, kt, i) * 128 + 16 * c8)); };
    auto fetch_v = [&](u32x4 (&v)[4], int qq, int kt) {
#pragma unroll
        for (int i = 0; i < 4; ++i) v[i] = *(const u32x4*)((const char*)AV + (size_t)(unsigned)(key_of(qq, kt, i) * 128 + 16 * c8)); };
    fetch_k(ks[0], 0, 0); fetch_v(vs[0], 0, 0); fetch_k(ks[1], 0, 1);
#pragma unroll 1
    for (int qq = 0; qq < 4; ++qq) {
        const int cc = __builtin_amdgcn_readfirstlane(cntp[qq]);
        f32x4v o[4]; float mrun = -INFINITY, lrun = 0.f;
#pragma unroll
        for (int dt = 0; dt < 4; ++dt) o[dt] = (f32x4v){0.f, 0.f, 0.f, 0.f};
        bf16x8 qf[2];
#pragma unroll
        for (int s = 0; s < 2; ++s) qf[s] = (c16 < 6) ? *(const LAS bf16x8*)(qrows + qq * 768 + c16 * 128 + 64 * s + 16 * g4) : (bf16x8){0, 0, 0, 0, 0, 0, 0, 0};
#pragma unroll
        for (int kt = 0; kt < 8; ++kt) {
            if (kt < 6) fetch_k(ks[(kt + 2) & 3], qq, kt + 2); else fetch_k(ks[(kt + 2) & 3], qq + 1, kt - 6);
            if (kt < 7) fetch_v(vs[(kt + 1) & 1], qq, kt + 1); else fetch_v(vs[(kt + 1) & 1], qq + 1, 0);
            if (32 * kt < cc) {
#pragma unroll
                for (int i = 0; i < 4; ++i) {
                    *(LAS u32x4*)(kbuf + (8 * i + l8) * 128 + 16 * (c8 ^ l8)) = ks[kt & 3][i];
                    *(LAS u32x4*)(vbuf + (8 * i + l8) * 128 + 16 * c8) = vs[kt & 1][i];
                }
                f32x4v st[2];
#pragma unroll
                for (int rt = 0; rt < 2; ++rt) {
                    const int row = 16 * rt + c16;
                    st[rt] = (f32x4v){0.f, 0.f, 0.f, 0.f};
#pragma unroll
                    for (int s = 0; s < 2; ++s) { const bf16x8 kf = *(const LAS bf16x8*)(kbuf + row * 128 + 16 * ((4 * s + g4) ^ (row & 7))); st[rt] = __builtin_amdgcn_mfma_f32_16x16x32_bf16(kf, qf[s], st[rt], 0, 0, 0); }
                }
                if (32 * (kt + 1) > cc) {
#pragma unroll
                    for (int rt = 0; rt < 2; ++rt)
#pragma unroll
                        for (int i = 0; i < 4; ++i) { const bool ok = (32 * kt + 16 * rt + 4 * g4 + i) < cc; st[rt][i] = ok ? st[rt][i] : -INFINITY; }
                }
                float mx = fmaxf(fmaxf(fmaxf(st[0][0], st[0][1]), fmaxf(st[0][2], st[0][3])), fmaxf(fmaxf(st[1][0], st[1][1]), fmaxf(st[1][2], st[1][3])));
                mx = xrow_max(mx);
                const float mnew = fmaxf(mrun, mx), msafe = (mnew == -INFINITY) ? 0.f : mnew;
                const float alpha = __builtin_amdgcn_exp2f(mrun - msafe);
                float p[8];
#pragma unroll
                for (int rt = 0; rt < 2; ++rt)
#pragma unroll
                    for (int i = 0; i < 4; ++i) p[4 * rt + i] = __builtin_amdgcn_exp2f(st[rt][i] - msafe);
                const float ls = ((p[0] + p[1]) + (p[2] + p[3])) + ((p[4] + p[5]) + (p[6] + p[7]));
                lrun = lrun * alpha + ls; mrun = mnew;
                u32x4 pw; pw.x = pkbf(p[0], p[1]); pw.y = pkbf(p[2], p[3]); pw.z = pkbf(p[4], p[5]); pw.w = pkbf(p[6], p[7]);
                const bf16x8 pb = __builtin_bit_cast(bf16x8, pw);
                const int q4 = c16 >> 2, p4 = c16 & 3;
                const LAS char* vb = vbuf + (4 * g4 + q4) * 128 + 8 * p4;
#pragma unroll
                for (int dt = 0; dt < 4; ++dt) {
                    const s16x4 lo = vtr(vb + dt * 32), hi = vtr(vb + dt * 32 + 16 * 128);
                    const bf16x8 va = __builtin_shufflevector(lo, hi, 0, 1, 2, 3, 4, 5, 6, 7);
                    o[dt] = o[dt] * alpha;
                    o[dt] = __builtin_amdgcn_mfma_f32_16x16x32_bf16(va, pb, o[dt], 0, 0, 0);
                }
            }
        }
        const float inv = 1.0f / xrow_sum(lrun);
        if (c16 < 6) {
            bf16_t* orow = (bf16_t*)(P.ws + WS_O) + (size_t)(tb + t0 + wave + 8 * qq) * KMERGE + c16 * 64 + 4 * g4;
#pragma unroll
            for (int dt = 0; dt < 4; ++dt) { u32x2 w; w.x = pkbf(o[dt][0] * inv, o[dt][1] * inv); w.y = pkbf(o[dt][2] * inv, o[dt][3] * inv); *(u32x2*)(orow + 16 * dt) = w; }
        }
    }
}

DI void dsa_phase(const Ptrs& P, LAS unsigned char* lds, int wave, int lane) {
    SUBT(7, lds);
    SUBT(0, lds);
    float* slab = P.out + (size_t)blockIdx.x * 32 * 4096;
    const int G = gridDim.x;
    for (int u = blockIdx.x; u < 1024; u += G) {
        const int p = u >> 8, wq = u & 255, b = wq & 7, k = wq >> 3;
        const int qb = (p == 0) ? k : (p == 1) ? 63 - k : (p == 2) ? 64 + k : 127 - k;
        dsa_unit(P, b, qb, slab, lds, wave, lane);
    }
}

struct WItem { const float* W; const float* gain; bf16_t* Bt; int ldw, srccol0, nvalid, K, v0, k0; };
DI void wconv_load(const WItem& I, float (&w)[32], f32x4 (&g)[2], int lane) {
    const int j = lane & 31;
#pragma unroll
    for (int i = 0; i < 32; ++i) { const int kk = 2 * i + (lane >> 5); w[i] = (j < I.nvalid) ? I.W[(size_t)(I.k0 + kk) * I.ldw + I.srccol0 + j] : 0.f; }
    if (I.gain) { g[0] = *(const f32x4*)(I.gain + I.k0 + 8 * (lane & 7)); g[1] = *(const f32x4*)(I.gain + I.k0 + 8 * (lane & 7) + 4); }
    else { g[0] = (f32x4){1.f, 1.f, 1.f, 1.f}; g[1] = g[0]; }
}
DI void wconv_store(const WItem& I, const float (&w)[32], const f32x4 (&g)[2], LAS float* scr, int lane) {
    const int j = lane & 31;
#pragma unroll
    for (int i = 0; i < 32; ++i) { const int kk = 2 * i + (lane >> 5); scr[kk * 33 + j] = w[i]; }
    asm volatile("s_waitcnt lgkmcnt(0)" ::: "memory");
    const int c = lane & 7;
#pragma unroll
    for (int jj = 0; jj < 4; ++jj) {
        const int n = (lane >> 3) + 8 * jj; const LAS float* s = scr + (8 * c) * 33 + n;
        u32x4 o; o.x = pkbf(s[0 * 33] * g[0].x, s[1 * 33] * g[0].y); o.y = pkbf(s[2 * 33] * g[0].z, s[3 * 33] * g[0].w); o.z = pkbf(s[4 * 33] * g[1].x, s[5 * 33] * g[1].y); o.w = pkbf(s[6 * 33] * g[1].z, s[7 * 33] * g[1].w);
        *(u32x4*)(I.Bt + (size_t)(I.v0 + n) * I.K + I.k0 + 8 * c) = o;
    }
    asm volatile("s_waitcnt lgkmcnt(0)" ::: "memory");
}
DI int qkv_slot_src(int slot) {
    if (slot < 6) return 64 * slot;
    if (slot == 6) return 384;
    if (slot == 7) return 448;
    if (slot < 16) return 512 + 64 * (slot - 8);
    if (slot == 16) return 1024;
    if (slot == 17) return 1088;
    if (slot < 30) return 1096 + 64 * (slot - 18);
    if (slot < 42) return 1864 + 64 * (slot - 30);
    if (slot < 54) return 2632 + 64 * (slot - 42);
    if (slot < 62) return 3400 + 64 * (slot - 54);
    if (slot < 64) return 3912 + 64 * (slot - 62);
    if (slot < 66) return 4040 + 64 * (slot - 64);
    return -1;
}
DI void weights_phase(const Ptrs& P, int layer, LAS unsigned char* lds, int wave, int lane) {
    LAS float* scr = (LAS float*)(lds + wave * 16384);
    const int gw = blockIdx.x * NWAVES + wave, NGW = gridDim.x * NWAVES;
    const float* w_in = P.w_in + (size_t)layer * DM * IN_W; const float* an = P.attn_norm + layer * DM; const float* mn = P.mlp_norm + layer * DM;
    const float* w_a = P.w_a + (size_t)layer * 384 * DM; const float* w_b = P.w_b + (size_t)layer * 256 * DM; const float* w_c = P.w_c + (size_t)layer * 512 * DM;
    const float* w_o = P.w_o + (size_t)layer * DM * DM; const float* w_up = P.w_up + (size_t)layer * DM * FF; const float* w_dn = P.w_down + (size_t)layer * FF * DM;
    bf16_t* Wqkv = (bf16_t*)(P.ws + WS_WQKV); bf16_t* Wg = (bf16_t*)(P.ws + WS_WG); bf16_t* Wm = (bf16_t*)(P.ws + WS_WM); bf16_t* Wo = (bf16_t*)(P.ws + WS_WO);
    bf16_t* Wup = (bf16_t*)(P.ws + WS_WUP); bf16_t* Wdn = (bf16_t*)(P.ws + WS_WDN);
    constexpr int I_QKV = 16 * (NQKV / 32), I_G = 16 * (NGATE / 32), I_M = 18 * 32, I_O = 16 * 32, I_UP = 16 * (FF / 32), I_DN = 64 * 32;
    constexpr int NITEMS = I_QKV + I_G + I_M + I_O + I_UP + I_DN;
    auto item_of = [&](int it) -> WItem {
        WItem I; int x = it;
        if (x < I_QKV) { const int kb = x / (NQKV / 32), vb = x % (NQKV / 32); const int pn = vb >> 3, bj = (vb >> 2) & 1, wc = vb & 3, slot = 4 * pn + wc; const int src = qkv_slot_src(slot);
            int nvalid = 32; if (src < 0) nvalid = 0; else if (slot == 17) nvalid = bj ? 0 : 8;
            I = WItem{w_in, an, Wqkv, IN_W, (src < 0 ? 0 : src) + 32 * bj, nvalid, DM, 32 * vb, 64 * kb}; return I; } x -= I_QKV;
        if (x < I_G) { const int kb = x / (NGATE / 32), vb = x % (NGATE / 32); I = WItem{w_in, an, Wg, IN_W, 4168 + 32 * vb, 32, DM, 32 * vb, 64 * kb}; return I; } x -= I_G;
        if (x < I_M) { const int kb = x / 32, vb = x % 32, k0 = 64 * kb;
            const float* src = (k0 < 384) ? w_a + (size_t)k0 * DM : (k0 < 640) ? w_b + (size_t)(k0 - 384) * DM : w_c + (size_t)(k0 - 640) * DM;
            I = WItem{src - (size_t)k0 * DM, nullptr, Wm, DM, 32 * vb, 32, KMERGE, 32 * vb, k0}; return I; } x -= I_M;
        if (x < I_O) { const int kb = x / 32, vb = x % 32; I = WItem{w_o, nullptr, Wo, DM, 32 * vb, 32, DM, 32 * vb, 64 * kb}; return I; } x -= I_O;
        if (x < I_UP) { const int kb = x / (FF / 32), vb = x % (FF / 32); I = WItem{w_up, mn, Wup, FF, 32 * vb, 32, DM, 32 * vb, 64 * kb}; return I; } x -= I_UP;
        { const int kb = x / 32, vb = x % 32; I = WItem{w_dn, nullptr, Wdn, DM, 32 * vb, 32, FF, 32 * vb, 64 * kb}; return I; }
    };
    int it = gw;
    if (it >= NITEMS) return;
    WItem C = item_of(it);
    float wn[32]; f32x4 gn[2];
    wconv_load(C, wn, gn, lane);
#pragma unroll 1
    for (; it < NITEMS; it += NGW) {
        float wc_[32]; f32x4 gc_[2];
#pragma unroll
        for (int i = 0; i < 32; ++i) wc_[i] = wn[i];
        gc_[0] = gn[0]; gc_[1] = gn[1];
        const int itn = (it + NGW < NITEMS) ? it + NGW : it;
        const WItem N = item_of(itn);
        wconv_load(N, wn, gn, lane);
        wconv_store(C, wc_, gc_, scr, lane);
        C = N;
    }
}

DI void sincos_d(double x, double& s, double& c) {
    const double k = __builtin_rint(x * 0.63661977236758134308);
    const double r0 = __builtin_fma(-k, 1.57079632679489655800e+00, x);
    const double r = __builtin_fma(-k, 6.12323399573676603587e-17, r0);
    const double z = r * r;
    double ps = -7.6471637318198164759e-13; ps = ps * z + 1.6059043836821614599e-10; ps = ps * z - 2.5052108385441718775e-08; ps = ps * z + 2.7557319223985890653e-06;
    ps = ps * z - 1.9841269841269841270e-04; ps = ps * z + 8.3333333333333333333e-03; ps = ps * z - 1.6666666666666666667e-01;
    const double sr = r + r * z * ps;
    double pc = 4.7794773323873852974e-14; pc = pc * z - 1.1470745597729724714e-11; pc = pc * z + 2.0876756987868098979e-09; pc = pc * z - 2.7557319223985890653e-07;
    pc = pc * z + 2.4801587301587301587e-05; pc = pc * z - 1.3888888888888888889e-03; pc = pc * z + 4.1666666666666666667e-02; pc = pc * z - 0.5;
    const double cr = 1.0 + z * pc;
    const int q = (int)((long long)k & 3);
    s = (q == 0) ? sr : (q == 1) ? cr : (q == 2) ? -sr : -cr;
    c = (q == 0) ? cr : (q == 1) ? -sr : (q == 2) ? -cr : sr;
}
DI void prologue_rows(const Ptrs& P, int wave, int lane) {
    const int gw = blockIdx.x * NWAVES + wave, NGW = gridDim.x * NWAVES;
    bf16_t* HB = (bf16_t*)(P.ws + WS_HB); float* SSQ = (float*)(P.ws + WS_SSQ); f32x2* CS = (f32x2*)(P.ws + WS_CS);
    const int fi = lane & 31;
    double invf = 1.0; { double bs = 0.74989420933245582730; int e = fi;
#pragma unroll
        for (int bit = 0; bit < 5; ++bit) { if (e & 1) invf *= bs; bs *= bs; e >>= 1; } }
    f32x4 vn[4];
    { const f32x4* xr = (const f32x4*)(P.x + (size_t)(gw < TOK ? gw : 0) * DM) + lane;
#pragma unroll
      for (int j = 0; j < 4; ++j) vn[j] = xr[64 * j]; }
    for (int m = gw; m < TOK; m += NGW) {
        f32x4 v[4]; float s = 0.f;
#pragma unroll
        for (int j = 0; j < 4; ++j) v[j] = vn[j];
        { const int mn = (m + NGW < TOK) ? m + NGW : m; const f32x4* xr = (const f32x4*)(P.x + (size_t)mn * DM) + lane;
#pragma unroll
          for (int j = 0; j < 4; ++j) vn[j] = xr[64 * j]; }
        const int posm = P.pos[m];
#pragma unroll
        for (int j = 0; j < 4; ++j) { const unsigned p0 = pkbf(v[j].x, v[j].y), p1 = pkbf(v[j].z, v[j].w); const float a = bflo(p0), b2 = bfhi(p0), c = bflo(p1), d = bfhi(p1); s += (a * a + b2 * b2) + (c * c + d * d); }
        s = wave_sum(s);
        u32x2* o8 = (u32x2*)(HB + (size_t)m * DM) + lane;
#pragma unroll
        for (int j = 0; j < 4; ++j) { u32x2 w; w.x = pkbf(v[j].x, v[j].y); w.y = pkbf(v[j].z, v[j].w); o8[64 * j] = w; }
        if (lane < 16) SSQ[(size_t)m * 16 + lane] = (lane == 0) ? s : 0.f;
        if (lane < 32) { double sn, cn; sincos_d((double)posm * invf, sn, cn); CS[(size_t)m * 32 + fi] = (f32x2){(float)cn, (float)sn}; }
    }
}
DI void final_norm_rows(const Ptrs& P, int wave, int lane) {
    const int gw = blockIdx.x * NWAVES + wave, NGW = gridDim.x * NWAVES;
    const float* SSQ = (const float*)(P.ws + WS_SSQ); const bf16_t* HB = (const bf16_t*)(P.ws + WS_HB);
    f32x4 g[4];
#pragma unroll
    for (int j = 0; j < 2; ++j) { g[2 * j] = *(const f32x4*)(P.final_norm + 512 * j + 8 * lane); g[2 * j + 1] = *(const f32x4*)(P.final_norm + 512 * j + 8 * lane + 4); }
    u32x4 hn[2]; float rsn;
    { const int m0 = gw < TOK ? gw : 0; hn[0] = *(const u32x4*)(HB + (size_t)m0 * DM + 8 * lane); hn[1] = *(const u32x4*)(HB + (size_t)m0 * DM + 512 + 8 * lane); rsn = pg8::row_rs(SSQ, m0); }
    for (int m = gw; m < TOK; m += NGW) {
        const u32x4 h0 = hn[0], h1 = hn[1]; const float rs = rsn;
        { const int mn = (m + NGW < TOK) ? m + NGW : m; hn[0] = *(const u32x4*)(HB + (size_t)mn * DM + 8 * lane); hn[1] = *(const u32x4*)(HB + (size_t)mn * DM + 512 + 8 * lane); rsn = pg8::row_rs(SSQ, mn); }
#pragma unroll
        for (int j = 0; j < 2; ++j) {
            const u32x4 hv = j ? h1 : h0;
            float* o = P.out + (size_t)m * DM + 512 * j + 8 * lane;
            *(f32x4*)o = (f32x4){bflo(hv.x), bfhi(hv.x), bflo(hv.y), bfhi(hv.y)} * rs * g[2 * j];
            *(f32x4*)(o + 4) = (f32x4){bflo(hv.z), bfhi(hv.z), bflo(hv.w), bfhi(hv.w)} * rs * g[2 * j + 1];
        }
    }
}

struct Args { Ptrs p; int ph_lo, ph_hi; };
__global__ void __launch_bounds__(NWAVES * 64, 2) hybrid_fwd(Args args) {
    extern __shared__ __attribute__((aligned(16))) unsigned char lds_raw[];
    LAS unsigned char* lds = (LAS unsigned char*)lds_raw;
    const Ptrs& P = args.p;
    const int tid = threadIdx.x; const int wave0 = __builtin_amdgcn_readfirstlane(tid >> 6);
    volatile LAS unsigned* MISC = (volatile LAS unsigned*)(lds + MISC_OFF);
    for (int u = tid; u < (LDS_BYTES - LDSCTL_OFF) / 4; u += NWAVES * 64) ((LAS unsigned*)(lds + LDSCTL_OFF))[u] = 0u;
    __syncthreads();
    const int lo = args.ph_lo, hi = args.ph_hi;
    const bool multi = (hi - lo) > 1;
    XcdBarrier bar; bar.bar = (unsigned*)(P.ws + WS_CTL) + CW_BAR; bar.x = 0; bar.st = nullptr;
    if (multi) bar = xcd_barrier_post((unsigned*)(P.ws + WS_CTL) + CW_BAR, MISC + 8);
#ifdef ONLY_PHASE
#define IN(k) (((k) == 0 ? 0 : ((k) == 9 ? 0 : ((k) == 18 ? 18 : ((k) - 1) % 9 + 1))) == ONLY_PHASE && lo <= (k) && (k) < hi)
#else
#define IN(k) (lo <= (k) && (k) < hi)
#endif
#define TSTAMP(k) do { if (PROBE_PHASE >= 0 && blockIdx.x == 0 && threadIdx.x == 0) ((volatile LAS unsigned long long*)(lds + LDSCTL_OFF + 1024))[(k)] = __builtin_amdgcn_s_memrealtime(); } while (0)
#define SEAM(k) do { if (IN(k) && IN((k) + 1)) xcd_barrier(bar); TSTAMP((k) + 1); } while (0)
    const int G = gridDim.x;
#define PHASE_IDS() const int lane = pg8::opaque_lane(), wave = wave0
    const pg8::bf16_t* HB = (const pg8::bf16_t*)(P.ws + WS_HB);
    float* SSQ = (float*)(P.ws + WS_SSQ);

    TSTAMP(0);
    if (IN(0)) { PHASE_IDS(); weights_phase(P, 0, lds, wave, lane); prologue_rows(P, wave, lane); SEAM(0); }
#pragma unroll 1
    for (int layer = 0; layer < DEPTH; ++layer) {
        const int pb = 1 + 9 * layer;
        if (layer == 1) { if (IN(9)) { PHASE_IDS(); weights_phase(P, 1, lds, wave, lane); SEAM(9); } }
        if (IN(pb + 0)) {
            pg8::Gemm g{HB, (const pg8::bf16_t*)(P.ws + WS_WQKV), TOK, NQKV, DM}; pg8::StaticOrder S; S.init(TOK, NQKV, G, (int)blockIdx.x);
            pg8::EpiQKV E; E.B.aq = (pg8::bf16_t*)(P.ws + WS_AQ); E.B.ak = (pg8::bf16_t*)(P.ws + WS_AK); E.B.av = (pg8::bf16_t*)(P.ws + WS_AV); E.B.iq = (pg8::bf16_t*)(P.ws + WS_IQ); E.B.ik = (pg8::bf16_t*)(P.ws + WS_IK);
            E.B.iw = (float*)(P.ws + WS_IW); E.B.bq = (pg8::bf16_t*)(P.ws + WS_BQ); E.B.bk = (pg8::bf16_t*)(P.ws + WS_BK); E.B.bv = (pg8::bf16_t*)(P.ws + WS_BV);
            E.B.cq = (pg8::bf16_t*)(P.ws + WS_CQ); E.B.ck = (pg8::bf16_t*)(P.ws + WS_CK); E.B.cv = (pg8::bf16_t*)(P.ws + WS_CV);
            E.ssq = SSQ; E.cs = (const pg8::f32x2*)(P.ws + WS_CS); E.iknorm = P.iknorm + layer * 64;
            pg8::gemm_phase<pg8::EpiQKV, pg8::StaticOrder, true, true>(lds, g, S, E, wave0);
            SEAM(pb + 0);
        }
        if (IN(pb + 1)) { PHASE_IDS();
            if (wave0 >= 4) __builtin_amdgcn_s_setprio(PRIO_LVL);
            attn_bc_phase2(P, layer, lds, wave, lane); __syncthreads(); if (!IN(pb + 2)) SEAM(pb + 1); }
        if (IN(pb + 2)) { PHASE_IDS(); dsa_phase(P, lds, wave, lane);
            __builtin_amdgcn_s_setprio(0);
            SEAM(pb + 2); }
        if (IN(pb + 3)) {
            { PHASE_IDS(); bmerge_rows(P, wave, lane); }
            pg8::Gemm g{HB, (const pg8::bf16_t*)(P.ws + WS_WG), TOK, NGATE, DM}; pg8::StaticOrder S; S.init(TOK, NGATE, G, (int)blockIdx.x);
            pg8::EpiAct<0> E{(pg8::bf16_t*)(P.ws + WS_GATES), NGATE, SSQ};
            pg8::gemm_phase<pg8::EpiAct<0>, pg8::StaticOrder, true, true>(lds, g, S, E, wave0);
            SEAM(pb + 3);
        }
        if (IN(pb + 4)) {
            pg8::Gemm g{(const pg8::bf16_t*)(P.ws + WS_O), (const pg8::bf16_t*)(P.ws + WS_WM), TOK, DM, KMERGE}; pg8::StaticOrder S; S.init(TOK, DM, G, (int)blockIdx.x);
            pg8::EpiMerge E{(const pg8::bf16_t*)(P.ws + WS_GATES), (pg8::bf16_t*)(P.ws + WS_MERGED)};
            pg8::gemm_phase<pg8::EpiMerge, pg8::StaticOrder, true, true>(lds, g, S, E, wave0);
            SEAM(pb + 4);
        }
        if (IN(pb + 5)) {
            pg8::Gemm g{(const pg8::bf16_t*)(P.ws + WS_MERGED), (const pg8::bf16_t*)(P.ws + WS_WO), TOK, DM, DM}; pg8::StaticOrder S; S.init(TOK, DM, G, (int)blockIdx.x);
            pg8::EpiResid E{(pg8::bf16_t*)(P.ws + WS_HB), SSQ};
            pg8::gemm_phase<pg8::EpiResid, pg8::StaticOrder, true, true>(lds, g, S, E, wave0);
            SEAM(pb + 5);
        }
        if (IN(pb + 6)) {
            pg8::Gemm g{HB, (const pg8::bf16_t*)(P.ws + WS_WUP), TOK, FF, DM}; pg8::StaticOrder S; S.init(TOK, FF, G, (int)blockIdx.x);
            pg8::EpiAct<1> E{(pg8::bf16_t*)(P.ws + WS_HID), FF, SSQ};
            pg8::gemm_phase<pg8::EpiAct<1>, pg8::StaticOrder, true, true>(lds, g, S, E, wave0);
            SEAM(pb + 6);
        }
        if (IN(pb + 7)) {
            pg8::Gemm g{(const pg8::bf16_t*)(P.ws + WS_HID), (const pg8::bf16_t*)(P.ws + WS_WDN), TOK, DM, FF}; pg8::StaticOrder S; S.init(TOK, DM, G, (int)blockIdx.x);
            pg8::EpiResid E{(pg8::bf16_t*)(P.ws + WS_HB), SSQ};
            pg8::gemm_phase<pg8::EpiResid, pg8::StaticOrder, true, true>(lds, g, S, E, wave0);
            SEAM(pb + 7);
        }
    }
    if (IN(18)) { PHASE_IDS(); final_norm_rows(P, wave, lane); }
    if (PROBE_PHASE >= 0 && blockIdx.x == 0 && threadIdx.x == 0) {
        volatile LAS unsigned long long* ts = (volatile LAS unsigned long long*)(lds + LDSCTL_OFF + 1024);
        const unsigned long long span = PROBE_PHASE >= 100 ? ((volatile LAS unsigned long long*)(lds + LDSCTL_OFF + 2048))[PROBE_PHASE - 100] : ts[PROBE_PHASE + 1] - ts[PROBE_PHASE], t0 = __builtin_amdgcn_s_memrealtime();
        while (__builtin_amdgcn_s_memrealtime() - t0 < 4ull * span) __builtin_amdgcn_s_sleep(8);
    }
#undef IN
#undef SEAM
}

extern "C" void kernel_launch(void* const* d_in, const int* in_sizes, int n_in, void* d_out, int out_size, void* d_ws, size_t ws_size, hipStream_t stream) {
    static int grid = 0;
    if (grid == 0) {
        if (n_in != 14 || in_sizes[0] != TOK * DM || out_size != TOK * DM || ws_size < WS_END) {
            fprintf(stderr, "kernel_launch: built for 14 inputs, x/out of %d floats, >= %zu bytes of workspace; got n_in %d, in0 %d, out %d, ws %zu; nothing launched\n", TOK * DM, (size_t)WS_END, n_in, n_in > 0 ? in_sizes[0] : -1, out_size, ws_size);
            grid = -1; return; }
        int dev = 0, cus = 0, per_cu = 0;
        if (hipGetDevice(&dev) != hipSuccess || hipDeviceGetAttribute(&cus, hipDeviceAttributeMultiprocessorCount, dev) != hipSuccess) { grid = -1; return; }
        if (hipFuncSetAttribute((const void*)hybrid_fwd, hipFuncAttributeMaxDynamicSharedMemorySize, LDS_BYTES) != hipSuccess) { fprintf(stderr, "kernel_launch: hipFuncSetAttribute failed\n"); grid = -1; return; }
        if (hipOccupancyMaxActiveBlocksPerMultiprocessor(&per_cu, (const void*)hybrid_fwd, NWAVES * 64, LDS_BYTES) != hipSuccess || per_cu < 1) { fprintf(stderr, "kernel_launch: occupancy query says %d blocks per CU\n", per_cu); grid = -1; (void)hipGetLastError(); return; }
        (void)hipGetLastError();
        grid = cus;
        if (grid > 256) grid = 256;
    }
    if (grid < 0) return;
    if (hipMemsetAsync((char*)d_ws + WS_CTL, 0, CTL_ZERO_BYTES, stream) != hipSuccess) return;
    Args a{};
    a.p.x = (const float*)d_in[0]; a.p.pos = (const int*)d_in[1]; a.p.attn_norm = (const float*)d_in[2]; a.p.w_in = (const float*)d_in[3]; a.p.iknorm = (const float*)d_in[4];
    a.p.sinks = (const float*)d_in[5]; a.p.w_a = (const float*)d_in[6]; a.p.w_b = (const float*)d_in[7]; a.p.w_c = (const float*)d_in[8]; a.p.w_o = (const float*)d_in[9];
    a.p.mlp_norm = (const float*)d_in[10]; a.p.w_up = (const float*)d_in[11]; a.p.w_down = (const float*)d_in[12]; a.p.final_norm = (const float*)d_in[13];
    a.p.out = (float*)d_out; a.p.ws = (unsigned char*)d_ws;
#if MK_ONE_LAUNCH
    a.ph_lo = 0; a.ph_hi = N_PHASES;
    hipLaunchKernelGGL(hybrid_fwd, dim3(grid), dim3(NWAVES * 64), LDS_BYTES, stream, a);
#else
    for (int ph = 0; ph < N_PHASES; ++ph) { a.ph_lo = ph; a.ph_hi = ph + 1; hipLaunchKernelGGL(hybrid_fwd, dim3(grid), dim3(NWAVES * 64), LDS_BYTES, stream, a); }
#endif
}
```

```cpp
#include <hip/hip_runtime.h>
#include <cstdio>
#include <cstdint>
#ifndef PROBE_PHASE
#define PROBE_PHASE -1
#endif
#define SUBT(i, lds_) do { if (PROBE_PHASE >= 100 && blockIdx.x == 0 && threadIdx.x == 0) { volatile __attribute__((address_space(3))) unsigned long long* a_ = (volatile __attribute__((address_space(3))) unsigned long long*)((lds_) + 131072 + 2048); const unsigned long long n_ = __builtin_amdgcn_s_memrealtime(); a_[(i)] += n_ - a_[8]; a_[8] = n_; } } while (0)
namespace pg8 {
#define PG8_LAS __attribute__((address_space(3)))
typedef unsigned short bf16_t;
typedef short bf16x8 __attribute__((ext_vector_type(8)));
typedef float f32x4 __attribute__((ext_vector_type(4)));
typedef unsigned u32x4 __attribute__((ext_vector_type(4)));
constexpr int BM = 256, BK = 64, HALF = 128, HTB = HALF * BK * 2  , STAGE_BYTES = 8 * HTB, NXCD = 8, WGM = 8;

__host__ __device__ __forceinline__ int lds_byte(int r, int c) { const int st = (r >> 4) * 2 + (c >> 5), rr = r & 15, cc = c & 31, ob = rr * 64 + cc * 2; return st * 1024 + (ob ^ (((ob >> 9) & 1) << 5)); }
__host__ __device__ __forceinline__ void stage_rc(int b, int& R, int& C) { const int st = b / 1024, sb = b % 1024, swz = sb ^ (((sb >> 9) & 1) << 5); R = (st >> 1) * 16 + swz / 64; C = (st & 1) * 32 + (swz % 64) / 2; }
__host__ __device__ __forceinline__ int perm32(int rho) { const int n = rho >> 4, i = rho & 15; return 8 * (i >> 2) + 4 * n + (i & 3); }

struct Unit { int pm, pn; };
struct Gemm { const bf16_t* A; const bf16_t* Bt; int M, N, K; };

struct StaticOrder {
    int nM, nN, nwg, G, c;
    __host__ __device__ void init(int M, int N, int G_, int c_) { nM = M / BM; nN = N / BM; nwg = nM * nN; G = G_; c = c_; }
    __host__ __device__ bool next(int i, Unit& u) const {
        const long L = (long)i * G + c; if (L >= nwg) return false;
        int wgid = (int)L; { const int q = nwg / NXCD, r = nwg % NXCD, xcd = wgid % NXCD, off = wgid / NXCD; wgid = (xcd < r ? xcd * (q + 1) : r * (q + 1) + (xcd - r) * q) + off; }
        const int nig = WGM * nN, gid = wgid / nig, fm = gid * WGM, gsz = (nM - fm) < WGM ? (nM - fm) : WGM;
        u.pm = fm + ((wgid % nig) % gsz); u.pn = (wgid % nig) / gsz; return true;
    }
    __device__ __forceinline__ void a_ready(const Unit&) const {}
    __device__ __forceinline__ void done(const Unit&) const {}
};

__device__ __forceinline__ int opaque_lane() { unsigned z = 0u; asm volatile("" : "+v"(z)); return (int)__builtin_amdgcn_mbcnt_hi(~0u, __builtin_amdgcn_mbcnt_lo(~0u, z)); }
typedef float f32x2 __attribute__((ext_vector_type(2)));
typedef __bf16 bf16x2_t __attribute__((ext_vector_type(2)));
typedef _Float16 f16x2_t __attribute__((ext_vector_type(2)));
__device__ __forceinline__ unsigned pkbf(float lo, float hi) { f32x2 v = {lo, hi}; bf16x2_t b = __builtin_convertvector(v, bf16x2_t); return __builtin_bit_cast(unsigned, b); }
__device__ __forceinline__ unsigned pkh(float lo, float hi) { f32x2 v = {lo, hi}; f16x2_t b = __builtin_convertvector(v, f16x2_t); return __builtin_bit_cast(unsigned, b); }
__device__ __forceinline__ float bflo(unsigned u) { return __builtin_bit_cast(float, u << 16); }
__device__ __forceinline__ float bfhi(unsigned u) { return __builtin_bit_cast(float, u & 0xffff0000u); }
constexpr int DMODEL = 1024;
constexpr float NORM_EPS = 1e-6f;
constexpr float QSCALE = 0.125f * 1.4426950408889634f;

__device__ __forceinline__ float row_rs(const float* ssq, int row) {
    const f32x4* p = (const f32x4*)(ssq + (size_t)row * 16);
    const f32x4 a = p[0], b = p[1], c = p[2], d = p[3];
    const float s = ((a.x + a.y) + (a.z + a.w)) + ((b.x + b.y) + (b.z + b.w)) + ((c.x + c.y) + (c.z + c.w)) + ((d.x + d.y) + (d.z + d.w));
    return 1.0f / sqrtf(s * (1.0f / DMODEL) + NORM_EPS);
}

__device__ __forceinline__ void wave_row_rs(const float* ssq, int rowbase  , int fr, int fq, float (&rs)[2][4]) {
    const int ai0 = fq >> 1, m0 = 2 * (fq & 1);
    const float ra = row_rs(ssq, rowbase + ai0 * HALF + m0 * 16), rb = row_rs(ssq, rowbase + ai0 * HALF + (m0 + 1) * 16);
#pragma unroll
    for (int ai = 0; ai < 2; ++ai)
#pragma unroll
        for (int m = 0; m < 4; ++m) { const int src = fr + 16 * (2 * ai + (m >> 1)); rs[ai][m] = __shfl((m & 1) ? rb : ra, src); }
}

struct QkvBufs { bf16_t *aq, *ak, *av, *iq, *ik, *bq, *bk, *bv, *cq, *ck, *cv; float* iw; };
struct EpiQKV {
    static constexpr bool PERM = true, AFTER_DRAIN = false, KHOOK = false; static constexpr int HOOK_T0 = -1, HOOK_T1 = -1;
    QkvBufs B; const float* ssq; const f32x2* cs; const float* iknorm;
    __device__ __forceinline__ void operator()(const f32x4 (&acc)[2][2][4][2], const Unit& u_, int wr, int wc, int fr_, int fq_) const {
        Unit u = u_; asm volatile("" : "+s"(u.pm), "+s"(u.pn)); const int ln_ = opaque_lane(); const int fr = ln_ & 15, fq = ln_ >> 4;
        const int slot = u.pn * 4 + wc;
        if (slot >= 66) return;
        int kind, pitch; bf16_t* dst; float scale = 1.f;
        if (slot < 6)        { kind = 1; dst = B.aq + slot * 64; pitch = 384; scale = QSCALE; }
        else if (slot == 6)  { kind = 1; dst = B.ak; pitch = 64; }
        else if (slot == 7)  { kind = 0; dst = B.av; pitch = 64; }
        else if (slot < 16)  { kind = 2; dst = B.iq + (slot - 8) * 64; pitch = 512; }
        else if (slot == 16) { kind = 3; dst = B.ik; pitch = 64; }
        else if (slot == 17) { kind = 4; dst = nullptr; pitch = 0; }
        else if (slot < 30)  { kind = 1; dst = B.bq + (slot - 18) * 64; pitch = 768; scale = QSCALE; }
        else if (slot < 42)  { kind = 1; dst = B.bk + (slot - 30) * 64; pitch = 768; }
        else if (slot < 54)  { kind = 0; dst = B.bv + (slot - 42) * 64; pitch = 768; }
        else if (slot < 62)  { kind = 1; dst = B.cq + (slot - 54) * 64; pitch = 512; scale = QSCALE; }
        else if (slot < 64)  { kind = 1; dst = B.ck + (slot - 62) * 64; pitch = 128; }
        else                 { kind = 0; dst = B.cv + (slot - 64) * 64; pitch = 128; }
        float rsv[2][4]; wave_row_rs(ssq, u.pm * BM + wr * 64 + fr, fr, fq, rsv);
#pragma unroll
        for (int ai = 0; ai < 2; ++ai)
#pragma unroll
            for (int m = 0; m < 4; ++m) {
                if ((m & 1) == 0) __builtin_amdgcn_sched_barrier(0);
                const int row = u.pm * BM + ai * HALF + wr * 64 + m * 16 + fr;
                const float rs = rsv[ai][m] * scale;
                f32x4 a0 = acc[ai][0][m][0] * rs, a1 = acc[ai][0][m][1] * rs, b0 = acc[ai][1][m][0] * rs, b1 = acc[ai][1][m][1] * rs;
                if (kind == 4) { if (fq == 0) { float* o = B.iw + (size_t)row * 8; *(f32x4*)o = a0; *(f32x4*)(o + 4) = a1; } continue; }
                if (kind == 3) {
                    float s = (a0.x * a0.x + a0.y * a0.y) + (a0.z * a0.z + a0.w * a0.w) + (a1.x * a1.x + a1.y * a1.y) + (a1.z * a1.z + a1.w * a1.w)
                            + (b0.x * b0.x + b0.y * b0.y) + (b0.z * b0.z + b0.w * b0.w) + (b1.x * b1.x + b1.y * b1.y) + (b1.z * b1.z + b1.w * b1.w);
                    s += __shfl_xor(s, 16); s += __shfl_xor(s, 32);
                    const float r2 = 1.0f / sqrtf(s * (1.0f / 64.f) + NORM_EPS);
                    a0 = a0 * r2 * *(const f32x4*)(iknorm + 8 * fq); a1 = a1 * r2 * *(const f32x4*)(iknorm + 8 * fq + 4); b0 = b0 * r2 * *(const f32x4*)(iknorm + 32 + 8 * fq); b1 = b1 * r2 * *(const f32x4*)(iknorm + 32 + 8 * fq + 4);
                }
                if (kind != 0) {
                    const f32x4* cp = (const f32x4*)(cs + (size_t)row * 32 + 8 * fq);
                    const f32x4 c0 = cp[0], c1 = cp[1], c2 = cp[2], c3 = cp[3];
                    f32x4 na0, na1, nb0, nb1;
                    na0.x = a0.x * c0.x - b0.x * c0.y; nb0.x = b0.x * c0.x + a0.x * c0.y;
                    na0.y = a0.y * c0.z - b0.y * c0.w; nb0.y = b0.y * c0.z + a0.y * c0.w;
                    na0.z = a0.z * c1.x - b0.z * c1.y; nb0.z = b0.z * c1.x + a0.z * c1.y;
                    na0.w = a0.w * c1.z - b0.w * c1.w; nb0.w = b0.w * c1.z + a0.w * c1.w;
                    na1.x = a1.x * c2.x - b1.x * c2.y; nb1.x = b1.x * c2.x + a1.x * c2.y;
                    na1.y = a1.y * c2.z - b1.y * c2.w; nb1.y = b1.y * c2.z + a1.y * c2.w;
                    na1.z = a1.z * c3.x - b1.z * c3.y; nb1.z = b1.z * c3.x + a1.z * c3.y;
                    na1.w = a1.w * c3.z - b1.w * c3.w; nb1.w = b1.w * c3.z + a1.w * c3.w;
                    a0 = na0; a1 = na1; b0 = nb0; b1 = nb1;
                }
                u32x4 wa, wb;
                if (kind >= 2) { wa.x = pkh(a0.x, a0.y); wa.y = pkh(a0.z, a0.w); wa.z = pkh(a1.x, a1.y); wa.w = pkh(a1.z, a1.w); wb.x = pkh(b0.x, b0.y); wb.y = pkh(b0.z, b0.w); wb.z = pkh(b1.x, b1.y); wb.w = pkh(b1.z, b1.w); }
                else           { wa.x = pkbf(a0.x, a0.y); wa.y = pkbf(a0.z, a0.w); wa.z = pkbf(a1.x, a1.y); wa.w = pkbf(a1.z, a1.w); wb.x = pkbf(b0.x, b0.y); wb.y = pkbf(b0.z, b0.w); wb.z = pkbf(b1.x, b1.y); wb.w = pkbf(b1.z, b1.w); }
#ifdef FULL_LINE_ST
                {
                    const bool lo8 = fr < 8;
                    u32x4 x, y;
                    x.x = lo8 ? wb.x : wa.x; x.y = lo8 ? wb.y : wa.y; x.z = lo8 ? wb.z : wa.z; x.w = lo8 ? wb.w : wa.w;
                    y.x = (unsigned)__builtin_amdgcn_update_dpp(0, (int)x.x, 0x128, 0xf, 0xf, true); y.y = (unsigned)__builtin_amdgcn_update_dpp(0, (int)x.y, 0x128, 0xf, 0xf, true);
                    y.z = (unsigned)__builtin_amdgcn_update_dpp(0, (int)x.z, 0x128, 0xf, 0xf, true); y.w = (unsigned)__builtin_amdgcn_update_dpp(0, (int)x.w, 0x128, 0xf, 0xf, true);
                    u32x4 s1, s2;
                    s1.x = lo8 ? wa.x : y.x; s1.y = lo8 ? wa.y : y.y; s1.z = lo8 ? wa.z : y.z; s1.w = lo8 ? wa.w : y.w;
                    s2.x = lo8 ? y.x : wb.x; s2.y = lo8 ? y.y : wb.y; s2.z = lo8 ? y.z : wb.z; s2.w = lo8 ? y.w : wb.w;
                    const int rbase = row - fr + (fr & 7);
                    bf16_t* o1 = dst + (size_t)rbase * pitch + 8 * fq + (lo8 ? 0 : 32);
                    *(u32x4*)o1 = s1; *(u32x4*)(o1 + (size_t)8 * pitch) = s2;
                }
#else
                bf16_t* o = dst + (size_t)row * pitch + 8 * fq;
                *(u32x4*)o = wa; *(u32x4*)(o + 32) = wb;
#endif
            }
    }
};

template <int ACT> struct EpiAct {
    static constexpr bool PERM = true, AFTER_DRAIN = false, KHOOK = false; static constexpr int HOOK_T0 = -1, HOOK_T1 = -1;
    bf16_t* O; int ldc; const float* ssq;
    __device__ __forceinline__ float act(float v) const {
        if (ACT == 0) { const float e = __builtin_amdgcn_exp2f(-1.4426950408889634f * v); const float g = __builtin_amdgcn_rcpf(1.0f + e); return fmaxf(g, 1e-20f); }
        const float r = fmaxf(v, 0.f); return r * r;
    }
    __device__ __forceinline__ void operator()(const f32x4 (&acc)[2][2][4][2], const Unit& u_, int wr, int wc, int fr_, int fq_) const {
        Unit u = u_; asm volatile("" : "+s"(u.pm), "+s"(u.pn)); const int ln_ = opaque_lane(); const int fr = ln_ & 15, fq = ln_ >> 4;
        const int col0 = u.pn * BM + wc * 32 + 8 * fq;
        float rsv[2][4]; wave_row_rs(ssq, u.pm * BM + wr * 64 + fr, fr, fq, rsv);
#pragma unroll
        for (int ai = 0; ai < 2; ++ai)
#pragma unroll
            for (int m = 0; m < 4; ++m) {
                const int row = u.pm * BM + ai * HALF + wr * 64 + m * 16 + fr;
                const float rs = rsv[ai][m];
                bf16_t* rowp = O + (size_t)row * ldc + col0;
#pragma unroll
                for (int bj = 0; bj < 2; ++bj) {
                    const f32x4 v0 = acc[ai][bj][m][0] * rs, v1 = acc[ai][bj][m][1] * rs;
                    u32x4 w; w.x = pkbf(act(v0.x), act(v0.y)); w.y = pkbf(act(v0.z), act(v0.w)); w.z = pkbf(act(v1.x), act(v1.y)); w.w = pkbf(act(v1.z), act(v1.w));
                    *(u32x4*)(rowp + bj * HALF) = w;
                }
            }
    }
};

struct EpiResid {
    static constexpr bool PERM = true, AFTER_DRAIN = false, KHOOK = false; static constexpr int HOOK_T0 = -1, HOOK_T1 = -1;
    bf16_t* hb; float* ssq;
    __device__ __forceinline__ void operator()(const f32x4 (&acc)[2][2][4][2], const Unit& u_, int wr, int wc, int fr_, int fq_) const {
        Unit u = u_; asm volatile("" : "+s"(u.pm), "+s"(u.pn)); const int ln_ = opaque_lane(); const int fr = ln_ & 15, fq = ln_ >> 4;
        const int col0 = u.pn * BM + wc * 32 + 8 * fq;
#pragma unroll
        for (int ai = 0; ai < 2; ++ai)
#pragma unroll
            for (int m = 0; m < 4; ++m) {
                const int row = u.pm * BM + ai * HALF + wr * 64 + m * 16 + fr;
                float ss = 0.f;
#pragma unroll
                for (int bj = 0; bj < 2; ++bj) {
                    const size_t off = (size_t)row * DMODEL + col0 + bj * HALF;
                    const u32x4 hv = *(const u32x4*)(hb + off);
                    const f32x4 a0 = acc[ai][bj][m][0], a1 = acc[ai][bj][m][1];
                    u32x4 w; w.x = pkbf(a0.x + bflo(hv.x), a0.y + bfhi(hv.x)); w.y = pkbf(a0.z + bflo(hv.y), a0.w + bfhi(hv.y));
                    w.z = pkbf(a1.x + bflo(hv.z), a1.y + bfhi(hv.z)); w.w = pkbf(a1.z + bflo(hv.w), a1.w + bfhi(hv.w));
                    *(u32x4*)(hb + off) = w;
                    const float r0 = bflo(w.x), r1 = bfhi(w.x), r2 = bflo(w.y), r3 = bfhi(w.y), r4 = bflo(w.z), r5 = bfhi(w.z), r6 = bflo(w.w), r7 = bfhi(w.w);
                    ss += (r0 * r0 + r1 * r1) + (r2 * r2 + r3 * r3) + (r4 * r4 + r5 * r5) + (r6 * r6 + r7 * r7);
                }
                ss += __shfl_xor(ss, 16); ss += __shfl_xor(ss, 32);
                if (fq == 0) ssq[(size_t)row * 16 + u.pn * 4 + wc] = ss;
            }
    }
};

struct EpiMerge {
    static constexpr bool PERM = true, AFTER_DRAIN = false, KHOOK = true; static constexpr int HOOK_T0 = 6, HOOK_T1 = 10;
    const bf16_t* gates; bf16_t* merged;
    __device__ __forceinline__ void khook(f32x4 (&acc)[2][2][4][2], const Unit& u_, int t, int wr, int wc, int fr_, int fq_) const {
        Unit u = u_; asm volatile("" : "+s"(u.pm), "+s"(u.pn)); const int ln_ = opaque_lane(); const int fr = ln_ & 15, fq = ln_ >> 4;
        const int col0 = u.pn * BM + wc * 32 + 8 * fq; const int bi = (t == HOOK_T0) ? 0 : 1;
        u32x4 ga[2][2][2], gb[2][2][2];
        auto ldc = [&](int slot, int ch) {
            const int ai = ch >> 1, mb = 2 * (ch & 1);
#pragma unroll
            for (int mm = 0; mm < 2; ++mm)
#pragma unroll
                for (int bj = 0; bj < 2; ++bj) {
                    const int row = u.pm * BM + ai * HALF + wr * 64 + (mb + mm) * 16 + fr;
                    const bf16_t* gp = gates + (size_t)row * 3072 + bi * 1024 + col0 + bj * HALF;
                    ga[slot][mm][bj] = *(const u32x4*)gp; gb[slot][mm][bj] = *(const u32x4*)(gp + 1024);
                }
        };
        ldc(0, 0);
#pragma unroll
        for (int ch = 0; ch < 4; ++ch) {
            const int ai = ch >> 1, mb = 2 * (ch & 1), sl = ch & 1;
            if (ch < 3) ldc(sl ^ 1, ch + 1);
#pragma unroll
            for (int mm = 0; mm < 2; ++mm)
#pragma unroll
                for (int bj = 0; bj < 2; ++bj) {
                    const int m = mb + mm;
                    const u32x4 a = ga[sl][mm][bj], b = gb[sl][mm][bj];
                    f32x4 r0, r1;
                    r0.x = bflo(a.x) * __builtin_amdgcn_rcpf(bflo(b.x)); r0.y = bfhi(a.x) * __builtin_amdgcn_rcpf(bfhi(b.x));
                    r0.z = bflo(a.y) * __builtin_amdgcn_rcpf(bflo(b.y)); r0.w = bfhi(a.y) * __builtin_amdgcn_rcpf(bfhi(b.y));
                    r1.x = bflo(a.z) * __builtin_amdgcn_rcpf(bflo(b.z)); r1.y = bfhi(a.z) * __builtin_amdgcn_rcpf(bfhi(b.z));
                    r1.z = bflo(a.w) * __builtin_amdgcn_rcpf(bflo(b.w)); r1.w = bfhi(a.w) * __builtin_amdgcn_rcpf(bfhi(b.w));
                    acc[ai][bj][m][0] = acc[ai][bj][m][0] * r0; acc[ai][bj][m][1] = acc[ai][bj][m][1] * r1;
                }
            __builtin_amdgcn_sched_barrier(0);
        }
    }
    __device__ __forceinline__ void operator()(const f32x4 (&acc)[2][2][4][2], const Unit& u_, int wr, int wc, int fr_, int fq_) const {
        Unit u = u_; asm volatile("" : "+s"(u.pm), "+s"(u.pn)); const int ln_ = opaque_lane(); const int fr = ln_ & 15, fq = ln_ >> 4;
        const int col0 = u.pn * BM + wc * 32 + 8 * fq;
#pragma unroll
        for (int ai = 0; ai < 2; ++ai)
#pragma unroll
            for (int m = 0; m < 4; ++m) {
                const int row = u.pm * BM + ai * HALF + wr * 64 + m * 16 + fr;
#pragma unroll
                for (int bj = 0; bj < 2; ++bj) {
                    const u32x4 g = *(const u32x4*)(gates + (size_t)row * 3072 + 2048 + col0 + bj * HALF);
                    const f32x4 a0 = acc[ai][bj][m][0], a1 = acc[ai][bj][m][1];
                    u32x4 w; w.x = pkbf(a0.x * bflo(g.x), a0.y * bfhi(g.x)); w.y = pkbf(a0.z * bflo(g.y), a0.w * bfhi(g.y));
                    w.z = pkbf(a1.x * bflo(g.z), a1.y * bfhi(g.z)); w.w = pkbf(a1.z * bflo(g.w), a1.w * bfhi(g.w));
                    *(u32x4*)(merged + (size_t)row * DMODEL + col0 + bj * HALF) = w;
                }
            }
    }
};
template <class Epi, class Sched, bool ALIGN_EPI = false, bool SP2 = false>
__device__ __forceinline__ void gemm_phase(PG8_LAS unsigned char* lds, const Gemm g, const Sched& S, const Epi& E, const int wid_in) {
    const int tid = wid_in * 64 + opaque_lane(), wid = wid_in       , lane = tid & 63, wr = wid >> 2, wc = wid & 3, fr = lane & 15, fq = lane >> 4;
    const int K = g.K, nt = K / BK;
    unsigned voffA[2], voffB[2];
#pragma unroll
    for (int i = 0; i < 2; ++i) { int R, C; stage_rc(tid * 16 + i * 8192, R, C); const int Rb = Epi::PERM ? ((R & ~31) + perm32(R & 31)) : R;
        voffA[i] = (unsigned)(R * K + C) * 2u; voffB[i] = (unsigned)(Rb * K + C) * 2u; }
    const size_t kstep = (size_t)(BK * 2);
    const size_t hstep = (size_t)HALF * K * 2;
    const size_t tstep = 2 * hstep;
    const unsigned ldsw = (unsigned)wid * 1024u;
    const int aoff = lds_byte(wr * 64 + fr, fq * 8), boff = lds_byte(wc * 32 + fr, fq * 8);
#define PG8_SA(b, h) (((b) * 2 + (h)) * HTB)
#define PG8_SB(b, h) ((4 + (b) * 2 + (h)) * HTB)
#define PG8_STAGE(bufoff, gbase, voff) do { _Pragma("unroll") for (int _i = 0; _i < 2; ++_i) \
        __builtin_amdgcn_global_load_lds((const unsigned*)((const char*)(gbase) + (voff)[_i]), (PG8_LAS unsigned*)(lds + (bufoff) + ldsw + _i * 8192), 16, 0, 0); } while (0)
#define PG8_LDA(dst, b, h) do { _Pragma("unroll") for (int m = 0; m < 4; ++m) _Pragma("unroll") for (int k = 0; k < 2; ++k) dst[m][k] = *(const PG8_LAS bf16x8*)(lds + PG8_SA(b, h) + aoff + m * 2048 + k * 1024); } while (0)
#define PG8_LDB(dst, b, h) do { _Pragma("unroll") for (int n = 0; n < 2; ++n) _Pragma("unroll") for (int k = 0; k < 2; ++k) dst[n][k] = *(const PG8_LAS bf16x8*)(lds + PG8_SB(b, h) + boff + n * 2048 + k * 1024); } while (0)
#define PG8_MMA(ai, bj, At, Bt) do { __builtin_amdgcn_s_setprio(1); _Pragma("unroll") for (int m = 0; m < 4; ++m) _Pragma("unroll") for (int n = 0; n < 2; ++n) _Pragma("unroll") for (int k = 0; k < 2; ++k) \
        acc[ai][bj][m][n] = __builtin_amdgcn_mfma_f32_16x16x32_bf16(Bt[n][k], At[m][k], acc[ai][bj][m][n], 0, 0, 0); __builtin_amdgcn_s_setprio(0); } while (0)
#define PG8_WAIT_V(n) asm volatile("s_waitcnt vmcnt(" #n ")" ::: "memory")
#define PG8_WAIT_L(n) asm volatile("s_waitcnt lgkmcnt(" #n ")" ::: "memory")
#define PG8_BAR __builtin_amdgcn_s_barrier()
#define PG8_SCHED __builtin_amdgcn_sched_barrier(0)
    Unit cur, nxt; int ui = 0;
    if (!S.next(0, cur)) return;
    f32x4 acc[2][2][4][2];
#pragma unroll
    for (int a = 0; a < 2; ++a)
#pragma unroll
        for (int b = 0; b < 2; ++b)
#pragma unroll
            for (int m = 0; m < 4; ++m)
#pragma unroll
                for (int n = 0; n < 2; ++n) acc[a][b][m][n] = (f32x4){0.f, 0.f, 0.f, 0.f};
    bf16x8 At[4][2], B0[2][2], B1[2][2];
    const char* cA = (const char*)g.A + (size_t)cur.pm * tstep; const char* cB = (const char*)g.Bt + (size_t)cur.pn * tstep;
    S.a_ready(cur);
    if constexpr (SP2) {
        PG8_STAGE(PG8_SB(0, 0), cB, voffB); PG8_STAGE(PG8_SB(0, 1), cB + hstep, voffB); PG8_STAGE(PG8_SA(0, 0), cA, voffA); PG8_STAGE(PG8_SA(0, 1), cA + hstep, voffA);
        if (wr == 1) PG8_BAR;
        PG8_WAIT_V(2); PG8_BAR;
        PG8_STAGE(PG8_SB(1, 0), cB + kstep, voffB); PG8_STAGE(PG8_SA(1, 0), cA + kstep, voffA); PG8_STAGE(PG8_SB(1, 1), cB + hstep + kstep, voffB);
        PG8_WAIT_V(6); PG8_BAR;
    } else {
        PG8_STAGE(PG8_SB(0, 0), cB, voffB); PG8_STAGE(PG8_SA(0, 0), cA, voffA); PG8_STAGE(PG8_SB(0, 1), cB + hstep, voffB); PG8_STAGE(PG8_SA(0, 1), cA + hstep, voffA);
        if (wr == 1) PG8_BAR;
        PG8_WAIT_V(4); PG8_BAR;
        PG8_STAGE(PG8_SB(1, 0), cB + kstep, voffB); PG8_STAGE(PG8_SA(1, 0), cA + kstep, voffA); PG8_STAGE(PG8_SB(1, 1), cB + hstep + kstep, voffB);
        PG8_WAIT_V(6); PG8_BAR;
    }
    for (;;) {
        const bool has_next = S.next(ui + 1, nxt);
        const char* nA = has_next ? (const char*)g.A + (size_t)nxt.pm * tstep : cA; const char* nB = has_next ? (const char*)g.Bt + (size_t)nxt.pn * tstep : cB;
        for (int t = 0; t < nt; t += 2) {
            if constexpr (Epi::KHOOK) { if (t == Epi::HOOK_T0 || t == Epi::HOOK_T1) E.khook(acc, cur, t, wr, wc, fr, fq); }
            const bool last = (t == nt - 2);
            const char* a1 = cA + (size_t)(t + 1) * kstep;
            const char* a2 = last ? nA : cA + (size_t)(t + 2) * kstep; const char* b2 = last ? nB : cB + (size_t)(t + 2) * kstep;
            const char* a3 = a2 + kstep; const char* b3 = b2 + kstep;
            if (last && has_next) S.a_ready(nxt);
            if constexpr (SP2) {
            PG8_LDB(B0, 0, 0); PG8_LDB(B1, 0, 1); PG8_SCHED; PG8_LDA(At, 0, 0); PG8_STAGE(PG8_SA(1, 1), a1 + hstep, voffA);
            PG8_WAIT_V(8); PG8_WAIT_L(0); PG8_BAR; PG8_MMA(0, 0, At, B0); PG8_MMA(0, 1, At, B1); PG8_BAR; PG8_SCHED;
            PG8_LDA(At, 0, 1); PG8_STAGE(PG8_SB(0, 0), b2, voffB); PG8_STAGE(PG8_SB(0, 1), b2 + hstep, voffB); PG8_STAGE(PG8_SA(0, 0), a2, voffA);
            PG8_WAIT_V(8); PG8_WAIT_L(0); PG8_BAR; PG8_MMA(1, 0, At, B0); PG8_MMA(1, 1, At, B1); PG8_BAR; PG8_SCHED;
            PG8_LDB(B0, 1, 0); PG8_LDB(B1, 1, 1); PG8_SCHED; PG8_LDA(At, 1, 0); PG8_STAGE(PG8_SA(0, 1), a2 + hstep, voffA);
            PG8_WAIT_V(8); PG8_WAIT_L(0); PG8_BAR; PG8_MMA(0, 0, At, B0); PG8_MMA(0, 1, At, B1); PG8_BAR; PG8_SCHED;
            PG8_LDA(At, 1, 1); PG8_STAGE(PG8_SB(1, 0), b3, voffB); PG8_STAGE(PG8_SB(1, 1), b3 + hstep, voffB); PG8_STAGE(PG8_SA(1, 0), a3, voffA);
            PG8_WAIT_V(8); PG8_WAIT_L(0); PG8_BAR; PG8_MMA(1, 0, At, B0); PG8_MMA(1, 1, At, B1); PG8_BAR; PG8_SCHED;
            } else {
            PG8_LDB(B0, 0, 0); PG8_SCHED; PG8_LDA(At, 0, 0); PG8_STAGE(PG8_SA(1, 1), a1 + hstep, voffA);
            PG8_WAIT_L(8); PG8_BAR; PG8_WAIT_L(0); PG8_MMA(0, 0, At, B0); PG8_BAR; PG8_SCHED;
            PG8_LDB(B1, 0, 1); PG8_STAGE(PG8_SB(0, 0), b2, voffB);
            PG8_BAR; PG8_WAIT_L(0); PG8_MMA(0, 1, At, B1); PG8_BAR;
            PG8_LDA(At, 0, 1); PG8_STAGE(PG8_SA(0, 0), a2, voffA);
            PG8_BAR; PG8_WAIT_L(0); PG8_MMA(1, 0, At, B0); PG8_BAR; PG8_SCHED;
            PG8_STAGE(PG8_SB(0, 1), b2 + hstep, voffB);
            PG8_WAIT_V(6); PG8_BAR; PG8_MMA(1, 1, At, B1); PG8_BAR;
            PG8_LDB(B0, 1, 0); PG8_SCHED; PG8_LDA(At, 1, 0); PG8_STAGE(PG8_SA(0, 1), a2 + hstep, voffA);
            PG8_WAIT_L(8); PG8_BAR; PG8_WAIT_L(0); PG8_MMA(0, 0, At, B0); PG8_BAR; PG8_SCHED;
            PG8_LDB(B1, 1, 1); PG8_STAGE(PG8_SB(1, 0), b3, voffB);
            PG8_BAR; PG8_WAIT_L(0); PG8_MMA(0, 1, At, B1); PG8_BAR;
            PG8_LDA(At, 1, 1); PG8_STAGE(PG8_SA(1, 0), a3, voffA);
            PG8_BAR; PG8_WAIT_L(0); PG8_MMA(1, 0, At, B0); PG8_BAR; PG8_SCHED;
            PG8_STAGE(PG8_SB(1, 1), b3 + hstep, voffB);
            PG8_WAIT_V(6); PG8_BAR; PG8_MMA(1, 1, At, B1); PG8_BAR;
            }
        }
        if constexpr (ALIGN_EPI) { if (wr == 0) PG8_BAR; }
        SUBT(9, lds);
        if constexpr (!Epi::AFTER_DRAIN) { E(acc, cur, wr, wc, fr, fq); S.done(cur); }
        SUBT(10, lds);
        if (!has_next) break;
#pragma unroll
        for (int a = 0; a < 2; ++a)
#pragma unroll
            for (int b = 0; b < 2; ++b)
#pragma unroll
                for (int m = 0; m < 4; ++m)
#pragma unroll
                    for (int n = 0; n < 2; ++n) acc[a][b][m][n] = (f32x4){0.f, 0.f, 0.f, 0.f};
        cur = nxt; cA = nA; cB = nB; ++ui;
        if constexpr (ALIGN_EPI) { if (wr == 1) PG8_BAR; }
    }
    PG8_WAIT_V(0);
    if constexpr (!ALIGN_EPI) { if (wr == 0) PG8_BAR; }
    PG8_BAR;
    if constexpr (Epi::AFTER_DRAIN) { E.fused(acc, cur, wr, wc, fr, fq, lds, wid, lane); S.done(cur); }
#undef PG8_SA
#undef PG8_SB
#undef PG8_STAGE
#undef PG8_LDA
#undef PG8_LDB
#undef PG8_MMA
#undef PG8_WAIT_V
#undef PG8_WAIT_L
#undef PG8_BAR
#undef PG8_SCHED
}
}
#define GAS __attribute__((address_space(1)))
#define LAS __attribute__((address_space(3)))
typedef unsigned short bf16;
typedef unsigned v4u __attribute__((ext_vector_type(4)));
typedef float f32x4 __attribute__((ext_vector_type(4)));
typedef short bf16x8 __attribute__((ext_vector_type(8)));
typedef GAS unsigned gu32;
typedef GAS unsigned long long gu64;
#define RLX_AGENT __ATOMIC_RELAXED, __HIP_MEMORY_SCOPE_AGENT
#define LDS_WAIT() asm volatile("s_waitcnt lgkmcnt(0)" ::: "memory")
#define VM_WAIT() asm volatile("s_waitcnt vmcnt(0)" ::: "memory")
__device__ __forceinline__ unsigned long long rt() { return __builtin_amdgcn_s_memrealtime(); }
__device__ __forceinline__ unsigned f2bf(float f) { unsigned u = __builtin_bit_cast(unsigned, f); return (u + 0x7fffu + ((u >> 16) & 1u)) >> 16; }
__device__ __forceinline__ unsigned pk2(float lo, float hi) { return f2bf(lo) | (f2bf(hi) << 16); }

#define XB_TMO      128
#define XB_XCNT(j)  (256  + 64 * (j))
#define XB_XSUB(j)  (1280 + 64 * (j))
#define XB_XGEN(j)  (2304 + 64 * (j))
#define XB_TOP      3328
#define XB_TOPGEN   3392
#define XCD_BAR_WORDS 3456
#define XB_SPIN_CAP (1u << 18)

__device__ __forceinline__ unsigned xb_ld(unsigned* p)              { return __hip_atomic_load(p, __ATOMIC_RELAXED, __HIP_MEMORY_SCOPE_AGENT); }
__device__ __forceinline__ unsigned xb_add(unsigned* p, unsigned v) { return __hip_atomic_fetch_add(p, v, __ATOMIC_RELAXED, __HIP_MEMORY_SCOPE_AGENT); }
__device__ __forceinline__ unsigned xb_xcc_id() { return (unsigned)__builtin_amdgcn_s_getreg((3 << 11) | 20) & 0xFu; }
#define XB_SPIN(cond, bar) do { unsigned _sp = 0; while (cond) { __builtin_amdgcn_s_sleep(1); \
    if ((++_sp & 255u) == 0u) { if (xb_ld(&(bar)[XB_TMO])) break; if (_sp > XB_SPIN_CAP) { atomicAdd(&(bar)[XB_TMO], 1u); break; } } } } while (0)

struct XcdBarrier {
    unsigned* bar; unsigned x;
    volatile LAS unsigned* st;
};

__device__ __forceinline__ XcdBarrier xcd_barrier_post(unsigned* bar, volatile LAS unsigned* st) {
    XcdBarrier b; b.bar = bar; b.x = xb_xcc_id(); b.st = st;
    if (threadIdx.x == 0) (void)xb_add(&bar[XB_XCNT(b.x)], 1u);
    return b;
}
__device__ __forceinline__ void xcd_barrier_complete(unsigned* bar, unsigned x, unsigned& nloc, unsigned& nx) {
    const unsigned G = gridDim.x * gridDim.y * gridDim.z;
    unsigned sum, cnt, mine, sp = 0u;
    for (;;) {
        sum = 0u; cnt = 0u; mine = 0u;
#pragma unroll
        for (unsigned j = 0; j < 16; ++j) { const unsigned c = xb_ld(&bar[XB_XCNT(j)]); sum += c; cnt += (c > 0u) ? 1u : 0u; mine = (j == x) ? c : mine; }
        if (sum == G) break;
        __builtin_amdgcn_s_sleep(1);
        if ((++sp & 255u) == 0u) { if (xb_ld(&bar[XB_TMO])) break; if (sp > XB_SPIN_CAP) { atomicAdd(&bar[XB_TMO], 1u); break; } }
    }
    nloc = mine > 0u ? mine : 1u; nx = cnt > 0u ? cnt : 1u;
}

__device__ __forceinline__ void xcd_barrier(const XcdBarrier& b) {
    asm volatile("s_waitcnt vmcnt(0)" ::: "memory");
    __syncthreads();
    if (threadIdx.x == 0) {
        unsigned* bar = b.bar;
        __builtin_amdgcn_s_waitcnt(0);
        unsigned nloc = b.st[0], nx = b.st[1];
        if (nloc == 0u) { xcd_barrier_complete(bar, b.x, nloc, nx); b.st[0] = nloc; b.st[1] = nx; }
        const unsigned old = xb_add(&bar[XB_XSUB(b.x)], 1u);
        const unsigned gen = old / nloc;
        if (old + 1u == (gen + 1u) * nloc) {
            __builtin_amdgcn_fence(__ATOMIC_RELEASE, "agent");
            asm volatile("s_waitcnt vmcnt(0)" ::: "memory");
            const unsigned og = xb_add(&bar[XB_TOP], 1u);
            const unsigned tg = og / nx;
            if (og + 1u == (tg + 1u) * nx) xb_add(&bar[XB_TOPGEN], 1u);
            else XB_SPIN(xb_ld(&bar[XB_TOPGEN]) == tg, bar);
            __builtin_amdgcn_fence(__ATOMIC_ACQUIRE, "agent");
            xb_add(&bar[XB_XGEN(b.x)], 1u);
            asm volatile("s_waitcnt vmcnt(0)" ::: "memory");
        } else {
            XB_SPIN(xb_ld(&bar[XB_XGEN(b.x)]) == gen, bar);
            __builtin_amdgcn_fence(__ATOMIC_ACQUIRE, "agent");
            asm volatile("s_waitcnt vmcnt(0)" ::: "memory");
        }
    }
    __syncthreads();
}

constexpr int NB = 8, SEQ = 4096, TOK = NB * SEQ, DM = 1024, FF = 4096, DEPTH = 2;
constexpr int IN_W = 7240;
constexpr int NQKV = 4352;
constexpr int NGATE = 3072, KMERGE = 1152;
constexpr int NWAVES = 8;
#ifndef MK_ONE_LAUNCH
#define MK_ONE_LAUNCH 1
#endif
#ifndef REPEAT_PHASE
#define REPEAT_PHASE 0
#endif
#define REP(k, ...) do { __VA_ARGS__ if (REPEAT_PHASE == (k)) { __VA_ARGS__ } } while (0)
#ifndef PRIO_LVL
#define PRIO_LVL 1
#endif
constexpr int N_PHASES = 19;

constexpr size_t MiB = 1u << 20;
constexpr size_t WS_CTL = 0, CTL_ZERO_BYTES = 1 * MiB;
constexpr size_t WS_WQKV = 1 * MiB;
constexpr size_t WS_WG   = WS_WQKV + (size_t)NQKV * DM * 2;
constexpr size_t WS_WM   = WS_WG + (size_t)NGATE * DM * 2;
constexpr size_t WS_WO   = WS_WM + (size_t)DM * KMERGE * 2;
constexpr size_t WS_WUP  = WS_WO + (size_t)DM * DM * 2;
constexpr size_t WS_WDN  = WS_WUP + (size_t)FF * DM * 2;
constexpr size_t WS_HB   = 36 * MiB;
constexpr size_t WS_SSQ  = 100 * MiB;
constexpr size_t WS_CS   = 102 * MiB;
constexpr size_t WS_O    = 110 * MiB;
constexpr size_t WS_OG   = 182 * MiB;
constexpr size_t WS_LSE  = 230 * MiB;
constexpr size_t WS_ZA   = 232 * MiB;
constexpr size_t WS_AQ = WS_ZA, WS_AK = WS_AQ + 24 * MiB, WS_AV = WS_AK + 4 * MiB, WS_IQ = WS_AV + 4 * MiB, WS_IK = WS_IQ + 32 * MiB, WS_IW = WS_IK + 4 * MiB;
constexpr size_t WS_ZBC  = 302 * MiB;
constexpr size_t WS_BQ = WS_ZBC, WS_BK = WS_BQ + 48 * MiB, WS_BV = WS_BK + 48 * MiB, WS_CQ = WS_BV + 48 * MiB, WS_CK = WS_CQ + 32 * MiB, WS_CV = WS_CK + 8 * MiB;
constexpr size_t WS_END  = 494 * MiB;
constexpr size_t WS_GATES = WS_ZBC;
constexpr size_t WS_MERGED = WS_ZA;
constexpr size_t WS_HID = WS_ZA;
static_assert(WS_WDN + (size_t)DM * FF * 2 <= WS_HB && WS_IW + (size_t)TOK * 8 * 4 <= WS_ZBC && WS_CV + 8 * MiB == WS_END && WS_HID + (size_t)TOK * FF * 2 <= WS_END, "d_ws map");
constexpr int CW_BAR = 4096;

constexpr int RING_BYTES = 131072;
constexpr int LDSCTL_OFF = RING_BYTES, MISC_OFF = LDSCTL_OFF + 320;
constexpr int LDS_BYTES = 147456;

typedef float f32x16 __attribute__((ext_vector_type(16)));
typedef float f32x2 __attribute__((ext_vector_type(2)));
typedef _Float16 f16x8 __attribute__((ext_vector_type(8)));
typedef short s16x4 __attribute__((ext_vector_type(4)));
typedef short v4i16_t __attribute__((ext_vector_type(4)));
typedef unsigned u32x2 __attribute__((ext_vector_type(2)));
#define DI __device__ __forceinline__
using pg8::pkbf; using pg8::bflo; using pg8::bfhi; using pg8::u32x4; using pg8::bf16_t;

DI int crow(int i, int h) { return (i & 3) + 8 * (i >> 2) + 4 * h; }
DI float wave_sum(float v) {
#pragma unroll
    for (int o = 1; o < 64; o <<= 1) v += __shfl_xor(v, o);
    return v;
}
DI s16x4 vtr(const LAS char* p) { return __builtin_bit_cast(s16x4, __builtin_amdgcn_ds_read_tr16_b64_v4i16((LAS v4i16_t*)p)); }

struct OState { f32x16 o0, o1; float m, l; };

DI float xhalf_max(float v) { auto rr = __builtin_amdgcn_permlane32_swap(__float_as_uint(v), __float_as_uint(v), false, false); return fmaxf(__uint_as_float(rr[0]), __uint_as_float(rr[1])); }
DI float xhalf_sum(float v) { auto rr = __builtin_amdgcn_permlane32_swap(__float_as_uint(v), __float_as_uint(v), false, false); return __uint_as_float(rr[0]) + __uint_as_float(rr[1]); }
DI void softmax_pv(OState& S, f32x16 s, const LAS char* vbuf, int lane) {
    const float m0 = fmaxf(fmaxf(s[0], s[1]), fmaxf(s[2], s[3])), m1 = fmaxf(fmaxf(s[4], s[5]), fmaxf(s[6], s[7]));
    const float m2 = fmaxf(fmaxf(s[8], s[9]), fmaxf(s[10], s[11])), m3 = fmaxf(fmaxf(s[12], s[13]), fmaxf(s[14], s[15]));
    const float mx = xhalf_max(fmaxf(fmaxf(m0, m1), fmaxf(m2, m3)));
    const float mnew = fmaxf(S.m, mx);
    const float msafe = (mnew == -INFINITY) ? 0.f : mnew;
    const float alpha = __builtin_amdgcn_exp2f(S.m - msafe);
    float p[16];
#pragma unroll
    for (int i = 0; i < 16; ++i) p[i] = __builtin_amdgcn_exp2f(s[i] - msafe);
    const float ls = ((p[0] + p[1]) + (p[2] + p[3])) + ((p[4] + p[5]) + (p[6] + p[7])) + (((p[8] + p[9]) + (p[10] + p[11])) + ((p[12] + p[13]) + (p[14] + p[15])));
    S.l = S.l * alpha + ls; S.m = mnew;
    S.o0 = S.o0 * alpha; S.o1 = S.o1 * alpha;
    u32x4 w0, w1;
    w0.x = pkbf(p[0], p[1]); w0.y = pkbf(p[2], p[3]); w0.z = pkbf(p[4], p[5]); w0.w = pkbf(p[6], p[7]);
    w1.x = pkbf(p[8], p[9]); w1.y = pkbf(p[10], p[11]); w1.z = pkbf(p[12], p[13]); w1.w = pkbf(p[14], p[15]);
    const bf16x8 pb0 = __builtin_bit_cast(bf16x8, w0), pb1 = __builtin_bit_cast(bf16x8, w1);
    const int h = lane >> 5, i16 = lane & 15, q = i16 >> 2, pp = i16 & 3, g16 = (lane >> 4) & 1;
    const LAS char* vb = vbuf + (4 * h + q) * 128 + (16 * g16 + 4 * pp) * 2;
#pragma unroll
    for (int dt = 0; dt < 2; ++dt) {
        const s16x4 lo0 = vtr(vb + dt * 64), hi0 = vtr(vb + dt * 64 + 8 * 128), lo1 = vtr(vb + dt * 64 + 16 * 128), hi1 = vtr(vb + dt * 64 + 24 * 128);
        const bf16x8 va0 = __builtin_shufflevector(lo0, hi0, 0, 1, 2, 3, 4, 5, 6, 7), va1 = __builtin_shufflevector(lo1, hi1, 0, 1, 2, 3, 4, 5, 6, 7);
        if (dt == 0) { S.o0 = __builtin_amdgcn_mfma_f32_32x32x16_bf16(va0, pb0, S.o0, 0, 0, 0); S.o0 = __builtin_amdgcn_mfma_f32_32x32x16_bf16(va1, pb1, S.o0, 0, 0, 0); }
        else         { S.o1 = __builtin_amdgcn_mfma_f32_32x32x16_bf16(va0, pb0, S.o1, 0, 0, 0); S.o1 = __builtin_amdgcn_mfma_f32_32x32x16_bf16(va1, pb1, S.o1, 0, 0, 0); }
    }
}

DI f32x16 zero16() { f32x16 z;
#pragma unroll
    for (int i = 0; i < 16; ++i) z[i] = 0.f;
    return z; }

DI void store_ot(const OState& S, bf16_t* orow, int h) {
    const float inv = 1.0f / xhalf_sum(S.l);
#pragma unroll
    for (int half = 0; half < 2; ++half)
#pragma unroll
        for (int gp = 0; gp < 2; ++gp) {
            const f32x16& o = half ? S.o1 : S.o0;
            const int g = 2 * gp;
            const unsigned ax = pkbf(o[4 * g] * inv, o[4 * g + 1] * inv), ay = pkbf(o[4 * g + 2] * inv, o[4 * g + 3] * inv);
            const unsigned bx = pkbf(o[4 * g + 4] * inv, o[4 * g + 5] * inv), by = pkbf(o[4 * g + 6] * inv, o[4 * g + 7] * inv);
            auto rx = __builtin_amdgcn_permlane32_swap(ax, bx, false, false);
            auto ry = __builtin_amdgcn_permlane32_swap(ay, by, false, false);
            u32x4 w; w.x = rx[0]; w.y = ry[0]; w.z = rx[1]; w.w = ry[1];
            *(u32x4*)(orow + 32 * half + 8 * g + 8 * h) = w;
        }
}

struct Ptrs {
    const float* x; const int* pos; const float *attn_norm, *w_in, *iknorm, *sinks, *w_a, *w_b, *w_c, *w_o, *mlp_norm, *w_up, *w_down, *final_norm;
    float* out; unsigned char* ws;
};

struct GDesc { const char* K; const char* V; const char* Q0; bf16_t* out; float* lse; int pq, pkv, po, tb, d, r0, i0g, W, ntile, typeC, head0; };
DI GDesc bc_gdesc(const Ptrs& P, int t) {
    GDesc D; const int b = t & 7; D.tb = b * SEQ;
    if (t < 1536) {
        const int rest = t >> 3, head = rest >> 4, grp = rest & 15, g = head >> 2, j = head & 3;
        D.d = (g == 0) ? 1 : (g == 1 ? 4 : 16);
        const int gpc = 16 / D.d;
        D.r0 = grp / gpc; D.i0g = 256 * (grp % gpc); D.W = 129; D.ntile = 12; D.typeC = 0; D.head0 = head;
        D.K = (const char*)((const bf16_t*)(P.ws + WS_BK) + head * 64); D.V = (const char*)((const bf16_t*)(P.ws + WS_BV) + head * 64); D.Q0 = (const char*)((const bf16_t*)(P.ws + WS_BQ) + head * 64);
        D.pq = 768 * 2; D.pkv = 768 * 2; D.po = 256;
        D.out = (bf16_t*)(P.ws + WS_OG) + (size_t)g * TOK * 256 + j * 64; D.lse = (float*)(P.ws + WS_LSE) + (size_t)g * TOK * 4 + j;
    } else {
        const int c = t - 1536, rest = c >> 3, kvh = rest >> 6, grp = rest & 63;
        D.d = 1; D.r0 = 0; D.i0g = 64 * grp; D.W = 128; D.ntile = 6; D.typeC = 1; D.head0 = 4 * kvh;
        D.K = (const char*)((const bf16_t*)(P.ws + WS_CK) + kvh * 64); D.V = (const char*)((const bf16_t*)(P.ws + WS_CV) + kvh * 64); D.Q0 = (const char*)((const bf16_t*)(P.ws + WS_CQ) + 4 * kvh * 64);
        D.pq = 512 * 2; D.pkv = 128 * 2; D.po = KMERGE;
        D.out = (bf16_t*)(P.ws + WS_O) + 640 + 4 * kvh * 64; D.lse = nullptr;
    }
    return D;
}
DI void attn_bc_phase2(const Ptrs& P, int layer, LAS unsigned char* lds, int wave, int lane) {
    const int G = gridDim.x, w = blockIdx.x;
    const int r = lane & 31, h = lane >> 5, tid = wave * 64 + lane;
    LAS char* kimg = (LAS char*)lds; LAS char* vimg = kimg + 49152;
    unsigned mlo129 = 0u, mlo128 = 0u, mhi = 0u;
#pragma unroll
    for (int i = 0; i < 16; ++i) { const int c = crow(i, h); mlo129 |= (c >= r) ? (1u << i) : 0u; mlo128 |= (c > r) ? (1u << i) : 0u; mhi |= (c <= r) ? (1u << i) : 0u; }
    auto img_ld = [&](u32x4 (&st)[12], const GDesc& D) {
        const int np = D.ntile * 32 * 8;
#pragma unroll
        for (int i = 0; i < 12; ++i) {
            const int p = tid + 512 * i;
            if (p < 2 * np) {
                const int isV = p >= np ? 1 : 0, q = p - isV * np, row = q >> 3, ch = q & 7;
                int cls = D.i0g - 128 + row; cls = cls < 0 ? 0 : cls;
                st[i] = *(const u32x4*)((isV ? D.V : D.K) + (size_t)(unsigned)((D.tb + D.r0 + D.d * cls) * D.pkv + 16 * ch));
            }
        }
    };
    auto img_st = [&](const u32x4 (&st)[12], const GDesc& D) {
        const int np = D.ntile * 32 * 8;
#pragma unroll
        for (int i = 0; i < 12; ++i) {
            const int p = tid + 512 * i;
            if (p < 2 * np) {
                const int isV = p >= np ? 1 : 0, q = p - isV * np, row = q >> 3, ch = q & 7;
                if (isV) *(LAS u32x4*)(vimg + row * 128 + 16 * ch) = st[i]; else *(LAS u32x4*)(kimg + row * 128 + 16 * (ch ^ (row & 7))) = st[i];
            }
        }
    };
    auto q_ld = [&](bf16x8 (&q)[4], const GDesc& D) {
        const int jq = D.typeC ? (wave & 1) : wave, hl = D.typeC ? (wave >> 1) : 0;
        const char* qr = D.Q0 + hl * 128 + (size_t)(D.tb + D.r0 + D.d * (D.i0g + 32 * jq + r)) * D.pq + 16 * h;
#pragma unroll
        for (int s = 0; s < 4; ++s) q[s] = *(const bf16x8*)(qr + 32 * s); };
    int t = w; const int tstride = G;
    if (t >= 2560) return;
    u32x4 stg[12]; bf16x8 qn[4];
    GDesc D = bc_gdesc(P, t);
    img_ld(stg, D); q_ld(qn, D);
#pragma unroll 1
    for (; t < 2560; t += tstride) {
        img_st(stg, D);
        bf16x8 qf[4];
#pragma unroll
        for (int s = 0; s < 4; ++s) qf[s] = qn[s];
        __syncthreads();
        const bool more = (t + tstride) < 2560;
        const GDesc N = bc_gdesc(P, more ? t + tstride : t);
        img_ld(stg, N); q_ld(qn, N);
        const int jq = D.typeC ? (wave & 1) : wave, hl = D.typeC ? (wave >> 1) : 0;
        OState S; S.o0 = zero16(); S.o1 = zero16();
        S.m = D.typeC ? P.sinks[layer * 8 + D.head0 + hl] * 1.4426950408889634f : -INFINITY; S.l = (D.typeC && h == 0) ? 1.f : 0.f;
        const unsigned mlo = (D.W == 129) ? mlo129 : mlo128;
        const int i0 = D.i0g + 32 * jq;
#pragma unroll
        for (int kt = 0; kt < 5; ++kt) {
            if (i0 - 128 + 32 * kt >= 0) {
                const LAS char* kb = kimg + (32 * (jq + kt)) * 128; const LAS char* vb = vimg + (32 * (jq + kt)) * 128;
                f32x16 st = zero16();
#pragma unroll
                for (int s = 0; s < 4; ++s) { const bf16x8 kf = *(const LAS bf16x8*)(kb + r * 128 + 16 * ((2 * s + h) ^ (r & 7))); st = __builtin_amdgcn_mfma_f32_32x32x16_bf16(kf, qf[s], st, 0, 0, 0); }
                if (kt == 0 || kt == 4) {
                    const unsigned mk = (kt == 0) ? mlo : mhi;
#pragma unroll
                    for (int i = 0; i < 16; ++i) st[i] = ((mk >> i) & 1u) ? st[i] : -INFINITY;
                }
                softmax_pv(S, st, vb, lane);
            }
        }
        const int tq = D.tb + D.r0 + D.d * (i0 + r);
        store_ot(S, D.out + hl * 64 + (size_t)tq * D.po, h);
        { const float lt = xhalf_sum(S.l); if (D.lse && h == 0) D.lse[(size_t)tq * 4] = S.m + __builtin_amdgcn_logf(lt); }
        __syncthreads();
        D = N;
    }
}

DI void bmerge_rows(const Ptrs& P, int wave, int lane) {
    const int G = gridDim.x;
    const bf16_t* og = (const bf16_t*)(P.ws + WS_OG); const float* lse = (const float*)(P.ws + WS_LSE); bf16_t* O = (bf16_t*)(P.ws + WS_O);
    const int j = lane >> 4, e = 4 * (lane & 15), NGW = G * NWAVES;
    int t = blockIdx.x * NWAVES + wave;
    if (t >= TOK) return;
    float ln[3]; u32x2 vn[3];
#pragma unroll
    for (int g = 0; g < 3; ++g) { ln[g] = lse[((size_t)g * TOK + t) * 4 + j]; vn[g] = *(const u32x2*)(og + ((size_t)g * TOK + t) * 256 + j * 64 + e); }
    for (; t < TOK; t += NGW) {
        const float l0 = ln[0], l1 = ln[1], l2 = ln[2]; const u32x2 v0 = vn[0], v1 = vn[1], v2 = vn[2];
        { const int tn = (t + NGW < TOK) ? t + NGW : t;
#pragma unroll
          for (int g = 0; g < 3; ++g) { ln[g] = lse[((size_t)g * TOK + tn) * 4 + j]; vn[g] = *(const u32x2*)(og + ((size_t)g * TOK + tn) * 256 + j * 64 + e); } }
        const float mx = fmaxf(l0, fmaxf(l1, l2));
        float a0 = __builtin_amdgcn_exp2f(l0 - mx), a1 = __builtin_amdgcn_exp2f(l1 - mx), a2 = __builtin_amdgcn_exp2f(l2 - mx);
        const float inv = 1.0f / (a0 + a1 + a2); a0 *= inv; a1 *= inv; a2 *= inv;
        u32x2 o;
        o.x = pkbf(a0 * bflo(v0.x) + a1 * bflo(v1.x) + a2 * bflo(v2.x), a0 * bfhi(v0.x) + a1 * bfhi(v1.x) + a2 * bfhi(v2.x));
        o.y = pkbf(a0 * bflo(v0.y) + a1 * bflo(v1.y) + a2 * bflo(v2.y), a0 * bfhi(v0.y) + a1 * bfhi(v1.y) + a2 * bfhi(v2.y));
        *(u32x2*)(O + (size_t)t * KMERGE + 384 + j * 64 + e) = o;
    }
}

DI float relu_i(float x) { const int xi = __builtin_bit_cast(int, x); return __builtin_bit_cast(float, xi > 0 ? xi : 0); }
DI unsigned mono_key(float f) { const unsigned u = __builtin_bit_cast(unsigned, f); return u ^ ((unsigned)((int)u >> 31) | 0x80000000u); }
DI unsigned lane_lt_count(unsigned long long m) { return __builtin_amdgcn_mbcnt_hi((unsigned)(m >> 32), __builtin_amdgcn_mbcnt_lo((unsigned)m, 0u)); }

DI unsigned wave_prefix_incl(unsigned v) {
    v += (unsigned)__builtin_amdgcn_update_dpp(0, (int)v, 0x111, 0xf, 0xf, true);
    v += (unsigned)__builtin_amdgcn_update_dpp(0, (int)v, 0x112, 0xf, 0xf, true);
    v += (unsigned)__builtin_amdgcn_update_dpp(0, (int)v, 0x114, 0xf, 0xf, true);
    v += (unsigned)__builtin_amdgcn_update_dpp(0, (int)v, 0x118, 0xf, 0xf, true);
    v += (unsigned)__builtin_amdgcn_update_dpp(0, (int)v, 0x142, 0xa, 0xf, true);
    v += (unsigned)__builtin_amdgcn_update_dpp(0, (int)v, 0x143, 0xc, 0xf, true);
    return v;
}
template <int LOGB> DI void hist_find(const LAS unsigned* hist, unsigned need, int lane, unsigned& B, unsigned& above, unsigned& cB) {
    constexpr int PER = (1 << LOGB) / 64;
    unsigned s = 0;
#pragma unroll
    for (int b = 0; b < PER; ++b) s += hist[lane * PER + ((b + lane) & (PER - 1))];
    const unsigned pre = wave_prefix_incl(s);
    const unsigned tot = (unsigned)__builtin_amdgcn_readlane((int)pre, 63);
    const unsigned suf = tot - pre + s;
    const unsigned long long mk = __ballot(suf >= need);
    const int Lc = 63 - __builtin_clzll(mk | 1ull);
    const unsigned run0 = (unsigned)__builtin_amdgcn_readlane((int)suf, Lc) - (unsigned)__builtin_amdgcn_readlane((int)s, Lc);
    const unsigned cb = (lane < PER) ? hist[Lc * PER + lane] : 0u;
    const unsigned pre2 = wave_prefix_incl(cb);
    const unsigned tot2 = (unsigned)__builtin_amdgcn_readlane((int)pre2, 63);
    const unsigned suf2 = tot2 - pre2 + cb;
    const unsigned long long mk2 = __ballot((lane < PER) && (run0 + suf2 >= need));
    const int bc = 63 - __builtin_clzll(mk2 | 1ull);
    B = (unsigned)(Lc * PER + bc); cB = (unsigned)__builtin_amdgcn_readlane((int)cb, bc); above = run0 + (unsigned)__builtin_amdgcn_readlane((int)suf2, bc) - cB;
}
template <int LOGB> DI void hist_zero(LAS unsigned* hist, int lane) {
    constexpr int N4 = (1 << LOGB) / 4 / 64;
#pragma unroll
    for (int i = 0; i < N4; ++i) ((LAS u32x4*)hist)[i * 64 + lane] = (u32x4){0u, 0u, 0u, 0u};
}

DI void select_top256(const float* row, int n, LAS unsigned* hist, LAS unsigned short* idx, int lane) {
    unsigned key[16][4];
    {
        f32x4 v[16];
        const int jmax = (n - 1) >> 8;
#pragma unroll
        for (int j = 0; j < 16; ++j) v[j] = *(const f32x4*)(row + 256 * (j <= jmax ? j : 0) + 4 * lane);
#pragma unroll
        for (int j = 0; j < 16; ++j)
#pragma unroll
            for (int c = 0; c < 4; ++c) key[j][c] = (256 * j + 4 * lane + c < n) ? mono_key(v[j][c]) : 0u;
    }
    unsigned B1, ab1, c1;
    hist_zero<11>(hist, lane);
#pragma unroll
    for (int j = 0; j < 16; ++j) if (256 * j < n) {
#pragma unroll
        for (int c = 0; c < 4; ++c) __hip_atomic_fetch_add(hist + (key[j][c] >> 21), 1u, __ATOMIC_RELAXED, __HIP_MEMORY_SCOPE_WAVEFRONT);
    }
    hist_find<11>(hist, 256u, lane, B1, ab1, c1);
    unsigned need = 256u - ab1;
    unsigned kgt, kstar = 0u, quota = 0u;
    if (c1 == need) { kgt = (B1 << 21) - 1u; }
    else {
        unsigned B2, ab2, c2;
        hist_zero<11>(hist, lane);
#pragma unroll
        for (int j = 0; j < 16; ++j) if (256 * j < n) {
#pragma unroll
            for (int c = 0; c < 4; ++c) { const unsigned k = key[j][c]; if ((k >> 21) == B1) __hip_atomic_fetch_add(hist + ((k >> 10) & 0x7ffu), 1u, __ATOMIC_RELAXED, __HIP_MEMORY_SCOPE_WAVEFRONT); }
        }
        hist_find<11>(hist, need, lane, B2, ab2, c2);
        need -= ab2;
        const unsigned pre = (B1 << 11) | B2;
        if (c2 == need) { kgt = (pre << 10) - 1u; }
        else {
            unsigned B3, ab3, c3;
            hist_zero<10>(hist, lane);
#pragma unroll
            for (int j = 0; j < 16; ++j) if (256 * j < n) {
#pragma unroll
                for (int c = 0; c < 4; ++c) { const unsigned k = key[j][c]; if ((k >> 10) == pre) __hip_atomic_fetch_add(hist + (k & 0x3ffu), 1u, __ATOMIC_RELAXED, __HIP_MEMORY_SCOPE_WAVEFRONT); }
            }
            hist_find<10>(hist, need, lane, B3, ab3, c3);
            need -= ab3;
            kstar = (pre << 10) | B3; kgt = kstar; quota = need;
        }
    }
    unsigned selm[16];
    unsigned eqn = 0, mycnt = 0;
#pragma unroll
    for (int j = 0; j < 16; ++j) {
        unsigned nib = 0u;
        if (256 * j < n) {
            if (quota != 0u) {
                bool eq[4]; unsigned below = 0u, tot = 0u;
#pragma unroll
                for (int c = 0; c < 4; ++c) { eq[c] = key[j][c] == kstar; const unsigned long long em = __ballot(eq[c]); below += lane_lt_count(em); tot += (unsigned)__builtin_popcountll(em); }
                unsigned run = eqn + below;
#pragma unroll
                for (int c = 0; c < 4; ++c) { const bool s = (key[j][c] > kgt) || (eq[c] && run < quota); run += eq[c] ? 1u : 0u; nib |= s ? (1u << c) : 0u; }
                eqn += tot;
            } else {
#pragma unroll
                for (int c = 0; c < 4; ++c) nib |= (key[j][c] > kgt) ? (1u << c) : 0u;
            }
        }
        selm[j] = nib; mycnt += (unsigned)__builtin_popcount(nib);
    }
    const unsigned pre = wave_prefix_incl(mycnt);
    unsigned pos = pre - mycnt;
    unsigned mlo = 0u, mhi = 0u;
#pragma unroll
    for (int j = 0; j < 8; ++j) { mlo |= selm[j] << (4 * j); mhi |= selm[8 + j] << (4 * j); }
    while (mlo | mhi) {
        unsigned e;
        if (mlo) { const unsigned bpos = (unsigned)__builtin_ctz(mlo); mlo &= mlo - 1u; e = ((bpos >> 2) << 8) + (bpos & 3u); }
        else     { const unsigned bpos = (unsigned)__builtin_ctz(mhi); mhi &= mhi - 1u; e = (((bpos >> 2) + 8u) << 8) + (bpos & 3u); }
        if (pos < 256u) idx[pos] = (unsigned short)(e + 4u * (unsigned)lane);
        ++pos;
    }
}

DI void dsa_rows(const Ptrs& P, int b, int qb, float* slab, LAS unsigned char* lds, int wave, int lane);
DI void dsa_unit(const Ptrs& P, int b, int qb, float* slab, LAS unsigned char* lds, int wave, int lane_) {
    const int lane = pg8::opaque_lane(); (void)lane_;
    const int r = lane & 31, h = lane >> 5, t0 = 32 * qb, tb = b * SEQ;
    {
        const _Float16* IQ = (const _Float16*)(P.ws + WS_IQ) + (size_t)(tb + t0 + r) * 512;
        const _Float16* IK = (const _Float16*)(P.ws + WS_IK) + (size_t)tb * 64;
        const float* IW = (const float*)(P.ws + WS_IW) + (size_t)(tb + t0 + r) * 8;
        LAS f16x8* QF = (LAS f16x8*)(lds + 81920);
#pragma unroll
        for (int s = 0; s < 4; ++s) QF[(wave * 4 + s) * 64 + lane] = *(const f16x8*)(IQ + wave * 64 + 16 * s + 8 * h);
        const f32x4 w03 = *(const f32x4*)IW, w47 = *(const f32x4*)(IW + 4);
        const float wv[8] = {w03.x, w03.y, w03.z, w03.w, w47.x, w47.y, w47.z, w47.w};
        __syncthreads();
        f16x8 kfn[4];
        { const _Float16* kr0 = IK + (size_t)(32 * (wave <= qb ? wave : qb) + r) * 64 + 8 * h;
#pragma unroll
          for (int s = 0; s < 4; ++s) kfn[s] = *(const f16x8*)(kr0 + 16 * s); }
#ifdef SCORE_STAGGER
        if (wave >= 4) { const unsigned long long t0s = __builtin_amdgcn_s_memrealtime(); while (__builtin_amdgcn_s_memrealtime() - t0s < SCORE_STAGGER) __builtin_amdgcn_s_sleep(2); }
#endif
#pragma unroll 1
        for (int kt = wave; kt <= qb; kt += NWAVES) {
            asm volatile("" ::: "memory");
            f16x8 kf[4];
#pragma unroll
            for (int s = 0; s < 4; ++s) kf[s] = kfn[s];
            { const int kn = (kt + NWAVES <= qb) ? kt + NWAVES : qb; const _Float16* kr = IK + (size_t)(32 * kn + r) * 64 + 8 * h;
#pragma unroll
              for (int s = 0; s < 4; ++s) kfn[s] = *(const f16x8*)(kr + 16 * s); }
            f32x16 sc = zero16();
            f16x8 qa[4], qb2[4];
#pragma unroll
            for (int s = 0; s < 4; ++s) { qa[s] = QF[s * 64 + lane]; qb2[s] = QF[(4 + s) * 64 + lane]; }
            f32x16 accA = zero16(), accB = zero16();
#pragma unroll
            for (int s = 0; s < 4; ++s) accA = __builtin_amdgcn_mfma_f32_32x32x16_f16(kf[s], qa[s], accA, 0, 0, 0);
            __builtin_amdgcn_sched_barrier(0);
#pragma unroll
            for (int hd = 0; hd < 8; ++hd) {
                if (hd < 7) {
                    if ((hd & 1) == 0) {
#pragma unroll
                        for (int s = 0; s < 4; ++s) accB = __builtin_amdgcn_mfma_f32_32x32x16_f16(kf[s], qb2[s], s == 0 ? zero16() : accB, 0, 0, 0);
                        if (hd < 6) {
#pragma unroll
                            for (int s = 0; s < 4; ++s) qa[s] = QF[((hd + 2) * 4 + s) * 64 + lane];
                        }
                    } else {
#pragma unroll
                        for (int s = 0; s < 4; ++s) accA = __builtin_amdgcn_mfma_f32_32x32x16_f16(kf[s], qa[s], s == 0 ? zero16() : accA, 0, 0, 0);
                        if (hd < 6) {
#pragma unroll
                            for (int s = 0; s < 4; ++s) qb2[s] = QF[((hd + 2) * 4 + s) * 64 + lane];
                        }
                    }
                }
                if ((hd & 1) == 0) {
#pragma unroll
                    for (int i = 0; i < 16; ++i) sc[i] = fmaf(wv[hd], relu_i(accA[i]), sc[i]);
                } else {
#pragma unroll
                    for (int i = 0; i < 16; ++i) sc[i] = fmaf(wv[hd], relu_i(accB[i]), sc[i]);
                }
                __builtin_amdgcn_sched_barrier(0);
            }
            float* o = slab + (size_t)r * 4096 + 32 * kt + 4 * h;
#pragma unroll
            for (int g = 0; g < 4; ++g) *(f32x4*)(o + 8 * g) = (f32x4){sc[4 * g], sc[4 * g + 1], sc[4 * g + 2], sc[4 * g + 3]};
        }
    }
    __syncthreads();
    SUBT(1, lds);
    const int lane2_ = pg8::opaque_lane();
    dsa_rows(P, b, qb, slab, lds, wave, lane2_);
    __syncthreads();
    SUBT(3, lds);
}

typedef float f32x4v __attribute__((ext_vector_type(4)));
DI float xrow_max(float v) {
    auto r1 = __builtin_amdgcn_permlane16_swap(__float_as_uint(v), __float_as_uint(v), false, false);
    return xhalf_max(fmaxf(__uint_as_float(r1[0]), __uint_as_float(r1[1])));
}
DI float xrow_sum(float v) {
    auto r1 = __builtin_amdgcn_permlane16_swap(__float_as_uint(v), __float_as_uint(v), false, false);
    return xhalf_sum(__uint_as_float(r1[0]) + __uint_as_float(r1[1]));
}
DI void dsa_rows(const Ptrs& P, int b, int qb, float* slab, LAS unsigned char* lds, int wave, int lane) {
    const int t0 = 32 * qb, tb = b * SEQ;
    LAS unsigned* hist = (LAS unsigned*)(lds + wave * 8192);
    LAS char* kbuf = (LAS char*)(lds + wave * 8192); LAS char* vbuf = kbuf + 4096;
    LAS char* qrows = (LAS char*)(lds + 81920 + wave * 3072);
    LAS int* cntp = (LAS int*)(lds + 81920 + 24576 + wave * 16);
    const bf16_t* AQ = (const bf16_t*)(P.ws + WS_AQ); const bf16_t* AK = (const bf16_t*)(P.ws + WS_AK) + (size_t)tb * 64; const bf16_t* AV = (const bf16_t*)(P.ws + WS_AV) + (size_t)tb * 64;
    u32x4 qst[4];
#pragma unroll
    for (int qq = 0; qq < 4; ++qq) qst[qq] = (lane < 48) ? *(const u32x4*)((const char*)(AQ + (size_t)(tb + t0 + wave + 8 * qq) * 384) + lane * 16) : (u32x4){0u, 0u, 0u, 0u};
#pragma unroll 1
    for (int qq = 0; qq < 4; ++qq) {
        const int q = wave + 8 * qq, t = t0 + q, n = t + 1;
        LAS unsigned short* idx = (LAS unsigned short*)(lds + 65536 + q * 512);
        int c;
        if (n <= 256) { for (int i = lane; i < n; i += 64) idx[i] = (unsigned short)i; c = n; }
        else { select_top256(slab + (size_t)q * 4096, n, hist, idx, lane); c = 256; }
        if (lane == 0) cntp[qq] = c;
    }
#pragma unroll
    for (int qq = 0; qq < 4; ++qq) if (lane < 48) *(LAS u32x4*)(qrows + qq * 768 + lane * 16) = qst[qq];
    SUBT(2, lds);
    const int c16 = lane & 15, g4 = lane >> 4, l8 = lane >> 3, c8 = lane & 7;
    u32x4 ks[4][4], vs[2][4];
    auto key_of = [&](int qq, int kt, int i) -> int {
        const int qe = qq < 4 ? qq : 3;
        const int cf = __builtin_amdgcn_readfirstlane(cntp[qe]);
        const int slot = 32 * kt + 8 * i + l8;
        const LAS unsigned short* idx = (const LAS unsigned short*)(lds + 65536 + (wave + 8 * qe) * 512);
        return (qq < 4 && slot < cf) ? (int)idx[slot] : 0;
    };
    auto fetch_k = [&](u32x4 (&k)[4], int qq, int kt) {
#pragma unroll
        for (int i = 0; i < 4; ++i) k[i] = *(const u32x4*)((const char*)AK + (size_t)(unsigned)(key_of(qq, kt, i) * 128 + 16 * c8)); };
    auto fetch_v = [&](u32x4 (&v)[4], int qq, int kt) {
#pragma unroll
        for (int i = 0; i < 4; ++i) v[i] = *(const u32x4*)((const char*)AV + (size_t)(unsigned)(key_of(qq, kt, i) * 128 + 16 * c8)); };
    fetch_k(ks[0], 0, 0); fetch_v(vs[0], 0, 0); fetch_k(ks[1], 0, 1);
#pragma unroll 1
    for (int qq = 0; qq < 4; ++qq) {
        const int cc = __builtin_amdgcn_readfirstlane(cntp[qq]);
        f32x4v o[4]; float mrun = -INFINITY, lrun = 0.f;
#pragma unroll
        for (int dt = 0; dt < 4; ++dt) o[dt] = (f32x4v){0.f, 0.f, 0.f, 0.f};
        bf16x8 qf[2];
#pragma unroll
        for (int s = 0; s < 2; ++s) qf[s] = (c16 < 6) ? *(const LAS bf16x8*)(qrows + qq * 768 + c16 * 128 + 64 * s + 16 * g4) : (bf16x8){0, 0, 0, 0, 0, 0, 0, 0};
#pragma unroll
        for (int kt = 0; kt < 8; ++kt) {
            if (kt < 6) fetch_k(ks[(kt + 2) & 3], qq, kt + 2); else fetch_k(ks[(kt + 2) & 3], qq + 1, kt - 6);
            if (kt < 7) fetch_v(vs[(kt + 1) & 1], qq, kt + 1); else fetch_v(vs[(kt + 1) & 1], qq + 1, 0);
            if (32 * kt < cc) {
#pragma unroll
                for (int i = 0; i < 4; ++i) {
                    *(LAS u32x4*)(kbuf + (8 * i + l8) * 128 + 16 * (c8 ^ l8)) = ks[kt & 3][i];
                    *(LAS u32x4*)(vbuf + (8 * i + l8) * 128 + 16 * c8) = vs[kt & 1][i];
                }
                f32x4v st[2];
#pragma unroll
                for (int rt = 0; rt < 2; ++rt) {
                    const int row = 16 * rt + c16;
                    st[rt] = (f32x4v){0.f, 0.f, 0.f, 0.f};
#pragma unroll
                    for (int s = 0; s < 2; ++s) { const bf16x8 kf = *(const LAS bf16x8*)(kbuf + row * 128 + 16 * ((4 * s + g4) ^ (row & 7))); st[rt] = __builtin_amdgcn_mfma_f32_16x16x32_bf16(kf, qf[s], st[rt], 0, 0, 0); }
                }
                if (32 * (kt + 1) > cc) {
#pragma unroll
                    for (int rt = 0; rt < 2; ++rt)
#pragma unroll
                        for (int i = 0; i < 4; ++i) { const bool ok = (32 * kt + 16 * rt + 4 * g4 + i) < cc; st[rt][i] = ok ? st[rt][i] : -INFINITY; }
                }
                float mx = fmaxf(fmaxf(fmaxf(st[0][0], st[0][1]), fmaxf(st[0][2], st[0][3])), fmaxf(fmaxf(st[1][0], st[1][1]), fmaxf(st[1][2], st[1][3])));
                mx = xrow_max(mx);
                const float mnew = fmaxf(mrun, mx), msafe = (mnew == -INFINITY) ? 0.f : mnew;
                const float alpha = __builtin_amdgcn_exp2f(mrun - msafe);
                float p[8];
#pragma unroll
                for (int rt = 0; rt < 2; ++rt)
#pragma unroll
                    for (int i = 0; i < 4; ++i) p[4 * rt + i] = __builtin_amdgcn_exp2f(st[rt][i] - msafe);
                const float ls = ((p[0] + p[1]) + (p[2] + p[3])) + ((p[4] + p[5]) + (p[6] + p[7]));
                lrun = lrun * alpha + ls; mrun = mnew;
                u32x4 pw; pw.x = pkbf(p[0], p[1]); pw.y = pkbf(p[2], p[3]); pw.z = pkbf(p[4], p[5]); pw.w = pkbf(p[6], p[7]);
                const bf16x8 pb = __builtin_bit_cast(bf16x8, pw);
                const int q4 = c16 >> 2, p4 = c16 & 3;
                const LAS char* vb = vbuf + (4 * g4 + q4) * 128 + 8 * p4;
#pragma unroll
                for (int dt = 0; dt < 4; ++dt) {
                    const s16x4 lo = vtr(vb + dt * 32), hi = vtr(vb + dt * 32 + 16 * 128);
                    const bf16x8 va = __builtin_shufflevector(lo, hi, 0, 1, 2, 3, 4, 5, 6, 7);
                    o[dt] = o[dt] * alpha;
                    o[dt] = __builtin_amdgcn_mfma_f32_16x16x32_bf16(va, pb, o[dt], 0, 0, 0);
                }
            }
        }
        const float inv = 1.0f / xrow_sum(lrun);
        LAS char* orow_l = qrows + qq * 768;
        if (c16 < 6) {
#pragma unroll
            for (int dt = 0; dt < 4; ++dt) { u32x2 w; w.x = pkbf(o[dt][0] * inv, o[dt][1] * inv); w.y = pkbf(o[dt][2] * inv, o[dt][3] * inv); *(LAS u32x2*)(orow_l + c16 * 128 + (16 * dt + 4 * g4) * 2) = w; }
        }
        if (lane < 48) *(u32x4*)((char*)((bf16_t*)(P.ws + WS_O) + (size_t)(tb + t0 + wave + 8 * qq) * KMERGE) + lane * 16) = *(const LAS u32x4*)(orow_l + lane * 16);
    }
}

DI void dsa_phase(const Ptrs& P, LAS unsigned char* lds, int wave, int lane) {
    SUBT(7, lds);
    SUBT(0, lds);
    float* slab = P.out + (size_t)blockIdx.x * 32 * 4096;
    const int G = gridDim.x;
    for (int u = blockIdx.x; u < 1024; u += G) {
        const int p = u >> 8, wq = u & 255, b = wq & 7, k = wq >> 3;
        const int qb = (p == 0) ? k : (p == 1) ? 63 - k : (p == 2) ? 64 + k : 127 - k;
        dsa_unit(P, b, qb, slab, lds, wave, lane);
    }
}

struct WItem { const float* W; const float* gain; bf16_t* Bt; int ldw, srccol0, nvalid, K, v0, k0; };
DI void wconv_load(const WItem& I, float (&w)[32], f32x4 (&g)[2], int lane) {
    const int j = lane & 31;
#pragma unroll
    for (int i = 0; i < 32; ++i) { const int kk = 2 * i + (lane >> 5); w[i] = (j < I.nvalid) ? I.W[(size_t)(I.k0 + kk) * I.ldw + I.srccol0 + j] : 0.f; }
    if (I.gain) { g[0] = *(const f32x4*)(I.gain + I.k0 + 8 * (lane & 7)); g[1] = *(const f32x4*)(I.gain + I.k0 + 8 * (lane & 7) + 4); }
    else { g[0] = (f32x4){1.f, 1.f, 1.f, 1.f}; g[1] = g[0]; }
}
DI void wconv_store(const WItem& I, const float (&w)[32], const f32x4 (&g)[2], LAS float* scr, int lane) {
    const int j = lane & 31;
#pragma unroll
    for (int i = 0; i < 32; ++i) { const int kk = 2 * i + (lane >> 5); scr[kk * 33 + j] = w[i]; }
    asm volatile("s_waitcnt lgkmcnt(0)" ::: "memory");
    const int c = lane & 7;
#pragma unroll
    for (int jj = 0; jj < 4; ++jj) {
        const int n = (lane >> 3) + 8 * jj; const LAS float* s = scr + (8 * c) * 33 + n;
        u32x4 o; o.x = pkbf(s[0 * 33] * g[0].x, s[1 * 33] * g[0].y); o.y = pkbf(s[2 * 33] * g[0].z, s[3 * 33] * g[0].w); o.z = pkbf(s[4 * 33] * g[1].x, s[5 * 33] * g[1].y); o.w = pkbf(s[6 * 33] * g[1].z, s[7 * 33] * g[1].w);
        *(u32x4*)(I.Bt + (size_t)(I.v0 + n) * I.K + I.k0 + 8 * c) = o;
    }
    asm volatile("s_waitcnt lgkmcnt(0)" ::: "memory");
}
DI int qkv_slot_src(int slot) {
    if (slot < 6) return 64 * slot;
    if (slot == 6) return 384;
    if (slot == 7) return 448;
    if (slot < 16) return 512 + 64 * (slot - 8);
    if (slot == 16) return 1024;
    if (slot == 17) return 1088;
    if (slot < 30) return 1096 + 64 * (slot - 18);
    if (slot < 42) return 1864 + 64 * (slot - 30);
    if (slot < 54) return 2632 + 64 * (slot - 42);
    if (slot < 62) return 3400 + 64 * (slot - 54);
    if (slot < 64) return 3912 + 64 * (slot - 62);
    if (slot < 66) return 4040 + 64 * (slot - 64);
    return -1;
}
DI void weights_phase(const Ptrs& P, int layer, LAS unsigned char* lds, int wave, int lane) {
    LAS float* scr = (LAS float*)(lds + wave * 16384);
    const int gw = blockIdx.x * NWAVES + wave, NGW = gridDim.x * NWAVES;
    const float* w_in = P.w_in + (size_t)layer * DM * IN_W; const float* an = P.attn_norm + layer * DM; const float* mn = P.mlp_norm + layer * DM;
    const float* w_a = P.w_a + (size_t)layer * 384 * DM; const float* w_b = P.w_b + (size_t)layer * 256 * DM; const float* w_c = P.w_c + (size_t)layer * 512 * DM;
    const float* w_o = P.w_o + (size_t)layer * DM * DM; const float* w_up = P.w_up + (size_t)layer * DM * FF; const float* w_dn = P.w_down + (size_t)layer * FF * DM;
    bf16_t* Wqkv = (bf16_t*)(P.ws + WS_WQKV); bf16_t* Wg = (bf16_t*)(P.ws + WS_WG); bf16_t* Wm = (bf16_t*)(P.ws + WS_WM); bf16_t* Wo = (bf16_t*)(P.ws + WS_WO);
    bf16_t* Wup = (bf16_t*)(P.ws + WS_WUP); bf16_t* Wdn = (bf16_t*)(P.ws + WS_WDN);
    constexpr int I_QKV = 16 * (NQKV / 32), I_G = 16 * (NGATE / 32), I_M = 18 * 32, I_O = 16 * 32, I_UP = 16 * (FF / 32), I_DN = 64 * 32;
    constexpr int NITEMS = I_QKV + I_G + I_M + I_O + I_UP + I_DN;
    auto item_of = [&](int it) -> WItem {
        WItem I; int x = it;
        if (x < I_QKV) { const int kb = x / (NQKV / 32), vb = x % (NQKV / 32); const int pn = vb >> 3, bj = (vb >> 2) & 1, wc = vb & 3, slot = 4 * pn + wc; const int src = qkv_slot_src(slot);
            int nvalid = 32; if (src < 0) nvalid = 0; else if (slot == 17) nvalid = bj ? 0 : 8;
            I = WItem{w_in, an, Wqkv, IN_W, (src < 0 ? 0 : src) + 32 * bj, nvalid, DM, 32 * vb, 64 * kb}; return I; } x -= I_QKV;
        if (x < I_G) { const int kb = x / (NGATE / 32), vb = x % (NGATE / 32); I = WItem{w_in, an, Wg, IN_W, 4168 + 32 * vb, 32, DM, 32 * vb, 64 * kb}; return I; } x -= I_G;
        if (x < I_M) { const int kb = x / 32, vb = x % 32, k0 = 64 * kb;
            const float* src = (k0 < 384) ? w_a + (size_t)k0 * DM : (k0 < 640) ? w_b + (size_t)(k0 - 384) * DM : w_c + (size_t)(k0 - 640) * DM;
            I = WItem{src - (size_t)k0 * DM, nullptr, Wm, DM, 32 * vb, 32, KMERGE, 32 * vb, k0}; return I; } x -= I_M;
        if (x < I_O) { const int kb = x / 32, vb = x % 32; I = WItem{w_o, nullptr, Wo, DM, 32 * vb, 32, DM, 32 * vb, 64 * kb}; return I; } x -= I_O;
        if (x < I_UP) { const int kb = x / (FF / 32), vb = x % (FF / 32); I = WItem{w_up, mn, Wup, FF, 32 * vb, 32, DM, 32 * vb, 64 * kb}; return I; } x -= I_UP;
        { const int kb = x / 32, vb = x % 32; I = WItem{w_dn, nullptr, Wdn, DM, 32 * vb, 32, FF, 32 * vb, 64 * kb}; return I; }
    };
    int it = gw;
    if (it >= NITEMS) return;
    WItem C = item_of(it);
    float wn[32]; f32x4 gn[2];
    wconv_load(C, wn, gn, lane);
#pragma unroll 1
    for (; it < NITEMS; it += NGW) {
        float wc_[32]; f32x4 gc_[2];
#pragma unroll
        for (int i = 0; i < 32; ++i) wc_[i] = wn[i];
        gc_[0] = gn[0]; gc_[1] = gn[1];
        const int itn = (it + NGW < NITEMS) ? it + NGW : it;
        const WItem N = item_of(itn);
        wconv_load(N, wn, gn, lane);
        wconv_store(C, wc_, gc_, scr, lane);
        C = N;
    }
}

DI void sincos_d(double x, double& s, double& c) {
    const double k = __builtin_rint(x * 0.63661977236758134308);
    const double r0 = __builtin_fma(-k, 1.57079632679489655800e+00, x);
    const double r = __builtin_fma(-k, 6.12323399573676603587e-17, r0);
    const double z = r * r;
    double ps = -7.6471637318198164759e-13; ps = ps * z + 1.6059043836821614599e-10; ps = ps * z - 2.5052108385441718775e-08; ps = ps * z + 2.7557319223985890653e-06;
    ps = ps * z - 1.9841269841269841270e-04; ps = ps * z + 8.3333333333333333333e-03; ps = ps * z - 1.6666666666666666667e-01;
    const double sr = r + r * z * ps;
    double pc = 4.7794773323873852974e-14; pc = pc * z - 1.1470745597729724714e-11; pc = pc * z + 2.0876756987868098979e-09; pc = pc * z - 2.7557319223985890653e-07;
    pc = pc * z + 2.4801587301587301587e-05; pc = pc * z - 1.3888888888888888889e-03; pc = pc * z + 4.1666666666666666667e-02; pc = pc * z - 0.5;
    const double cr = 1.0 + z * pc;
    const int q = (int)((long long)k & 3);
    s = (q == 0) ? sr : (q == 1) ? cr : (q == 2) ? -sr : -cr;
    c = (q == 0) ? cr : (q == 1) ? -sr : (q == 2) ? -cr : sr;
}
DI void prologue_rows(const Ptrs& P, int wave, int lane) {
    const int gw = blockIdx.x * NWAVES + wave, NGW = gridDim.x * NWAVES;
    bf16_t* HB = (bf16_t*)(P.ws + WS_HB); float* SSQ = (float*)(P.ws + WS_SSQ); f32x2* CS = (f32x2*)(P.ws + WS_CS);
    const int fi = lane & 31;
    double invf = 1.0; { double bs = 0.74989420933245582730; int e = fi;
#pragma unroll
        for (int bit = 0; bit < 5; ++bit) { if (e & 1) invf *= bs; bs *= bs; e >>= 1; } }
    f32x4 vn[4];
    { const f32x4* xr = (const f32x4*)(P.x + (size_t)(gw < TOK ? gw : 0) * DM) + lane;
#pragma unroll
      for (int j = 0; j < 4; ++j) vn[j] = xr[64 * j]; }
    for (int m = gw; m < TOK; m += NGW) {
        f32x4 v[4]; float s = 0.f;
#pragma unroll
        for (int j = 0; j < 4; ++j) v[j] = vn[j];
        { const int mn = (m + NGW < TOK) ? m + NGW : m; const f32x4* xr = (const f32x4*)(P.x + (size_t)mn * DM) + lane;
#pragma unroll
          for (int j = 0; j < 4; ++j) vn[j] = xr[64 * j]; }
        const int posm = P.pos[m];
#pragma unroll
        for (int j = 0; j < 4; ++j) { const unsigned p0 = pkbf(v[j].x, v[j].y), p1 = pkbf(v[j].z, v[j].w); const float a = bflo(p0), b2 = bfhi(p0), c = bflo(p1), d = bfhi(p1); s += (a * a + b2 * b2) + (c * c + d * d); }
        s = wave_sum(s);
        u32x2* o8 = (u32x2*)(HB + (size_t)m * DM) + lane;
#pragma unroll
        for (int j = 0; j < 4; ++j) { u32x2 w; w.x = pkbf(v[j].x, v[j].y); w.y = pkbf(v[j].z, v[j].w); o8[64 * j] = w; }
        if (lane < 16) SSQ[(size_t)m * 16 + lane] = (lane == 0) ? s : 0.f;
        if (lane < 32) { double sn, cn; sincos_d((double)posm * invf, sn, cn); CS[(size_t)m * 32 + fi] = (f32x2){(float)cn, (float)sn}; }
    }
}
DI void final_norm_rows(const Ptrs& P, int wave, int lane) {
    const int gw = blockIdx.x * NWAVES + wave, NGW = gridDim.x * NWAVES;
    const float* SSQ = (const float*)(P.ws + WS_SSQ); const bf16_t* HB = (const bf16_t*)(P.ws + WS_HB);
    f32x4 g[4];
#pragma unroll
    for (int j = 0; j < 2; ++j) { g[2 * j] = *(const f32x4*)(P.final_norm + 512 * j + 8 * lane); g[2 * j + 1] = *(const f32x4*)(P.final_norm + 512 * j + 8 * lane + 4); }
    u32x4 hn[2]; float rsn;
    { const int m0 = gw < TOK ? gw : 0; hn[0] = *(const u32x4*)(HB + (size_t)m0 * DM + 8 * lane); hn[1] = *(const u32x4*)(HB + (size_t)m0 * DM + 512 + 8 * lane); rsn = pg8::row_rs(SSQ, m0); }
    for (int m = gw; m < TOK; m += NGW) {
        const u32x4 h0 = hn[0], h1 = hn[1]; const float rs = rsn;
        { const int mn = (m + NGW < TOK) ? m + NGW : m; hn[0] = *(const u32x4*)(HB + (size_t)mn * DM + 8 * lane); hn[1] = *(const u32x4*)(HB + (size_t)mn * DM + 512 + 8 * lane); rsn = pg8::row_rs(SSQ, mn); }
#pragma unroll
        for (int j = 0; j < 2; ++j) {
            const u32x4 hv = j ? h1 : h0;
            float* o = P.out + (size_t)m * DM + 512 * j + 8 * lane;
            *(f32x4*)o = (f32x4){bflo(hv.x), bfhi(hv.x), bflo(hv.y), bfhi(hv.y)} * rs * g[2 * j];
            *(f32x4*)(o + 4) = (f32x4){bflo(hv.z), bfhi(hv.z), bflo(hv.w), bfhi(hv.w)} * rs * g[2 * j + 1];
        }
    }
}

struct Args { Ptrs p; int ph_lo, ph_hi; };
__global__ void __launch_bounds__(NWAVES * 64, 2) hybrid_fwd(Args args) {
    extern __shared__ __attribute__((aligned(16))) unsigned char lds_raw[];
    LAS unsigned char* lds = (LAS unsigned char*)lds_raw;
    const Ptrs& P = args.p;
    const int tid = threadIdx.x; const int wave0 = __builtin_amdgcn_readfirstlane(tid >> 6);
    volatile LAS unsigned* MISC = (volatile LAS unsigned*)(lds + MISC_OFF);
    for (int u = tid; u < (LDS_BYTES - LDSCTL_OFF) / 4; u += NWAVES * 64) ((LAS unsigned*)(lds + LDSCTL_OFF))[u] = 0u;
    __syncthreads();
    const int lo = args.ph_lo, hi = args.ph_hi;
    const bool multi = (hi - lo) > 1;
    XcdBarrier bar; bar.bar = (unsigned*)(P.ws + WS_CTL) + CW_BAR; bar.x = 0; bar.st = nullptr;
    if (multi) bar = xcd_barrier_post((unsigned*)(P.ws + WS_CTL) + CW_BAR, MISC + 8);
#ifdef ONLY_PHASE
#define IN(k) (((k) == 0 ? 0 : ((k) == 9 ? 0 : ((k) == 18 ? 18 : ((k) - 1) % 9 + 1))) == ONLY_PHASE && lo <= (k) && (k) < hi)
#else
#define IN(k) (lo <= (k) && (k) < hi)
#endif
#define TSTAMP(k) do { if (PROBE_PHASE >= 0 && blockIdx.x == 0 && threadIdx.x == 0) ((volatile LAS unsigned long long*)(lds + LDSCTL_OFF + 1024))[(k)] = __builtin_amdgcn_s_memrealtime(); } while (0)
#define SEAM(k) do { if (IN(k) && IN((k) + 1)) xcd_barrier(bar); TSTAMP((k) + 1); } while (0)
    const int G = gridDim.x;
#define PHASE_IDS() const int lane = pg8::opaque_lane(), wave = wave0
    const pg8::bf16_t* HB = (const pg8::bf16_t*)(P.ws + WS_HB);
    float* SSQ = (float*)(P.ws + WS_SSQ);

    TSTAMP(0);
    if (IN(0)) { PHASE_IDS(); weights_phase(P, 0, lds, wave, lane); prologue_rows(P, wave, lane); SEAM(0); }
#pragma unroll 1
    for (int layer = 0; layer < DEPTH; ++layer) {
        const int pb = 1 + 9 * layer;
        if (layer == 1) { if (IN(9)) { PHASE_IDS(); weights_phase(P, 1, lds, wave, lane); SEAM(9); } }
        if (IN(pb + 0)) {
            pg8::Gemm g{HB, (const pg8::bf16_t*)(P.ws + WS_WQKV), TOK, NQKV, DM}; pg8::StaticOrder S; S.init(TOK, NQKV, G, (int)blockIdx.x);
            pg8::EpiQKV E; E.B.aq = (pg8::bf16_t*)(P.ws + WS_AQ); E.B.ak = (pg8::bf16_t*)(P.ws + WS_AK); E.B.av = (pg8::bf16_t*)(P.ws + WS_AV); E.B.iq = (pg8::bf16_t*)(P.ws + WS_IQ); E.B.ik = (pg8::bf16_t*)(P.ws + WS_IK);
            E.B.iw = (float*)(P.ws + WS_IW); E.B.bq = (pg8::bf16_t*)(P.ws + WS_BQ); E.B.bk = (pg8::bf16_t*)(P.ws + WS_BK); E.B.bv = (pg8::bf16_t*)(P.ws + WS_BV);
            E.B.cq = (pg8::bf16_t*)(P.ws + WS_CQ); E.B.ck = (pg8::bf16_t*)(P.ws + WS_CK); E.B.cv = (pg8::bf16_t*)(P.ws + WS_CV);
            E.ssq = SSQ; E.cs = (const pg8::f32x2*)(P.ws + WS_CS); E.iknorm = P.iknorm + layer * 64;
            pg8::gemm_phase<pg8::EpiQKV, pg8::StaticOrder, true, true>(lds, g, S, E, wave0);
            SEAM(pb + 0);
        }
        if (IN(pb + 1)) { PHASE_IDS();
            if (wave0 >= 4) __builtin_amdgcn_s_setprio(PRIO_LVL);
            attn_bc_phase2(P, layer, lds, wave, lane); __syncthreads(); if (!IN(pb + 2)) SEAM(pb + 1); }
        if (IN(pb + 2)) { PHASE_IDS(); dsa_phase(P, lds, wave, lane);
            __builtin_amdgcn_s_setprio(0);
            SEAM(pb + 2); }
        if (IN(pb + 3)) {
            { PHASE_IDS(); bmerge_rows(P, wave, lane); }
            pg8::Gemm g{HB, (const pg8::bf16_t*)(P.ws + WS_WG), TOK, NGATE, DM}; pg8::StaticOrder S; S.init(TOK, NGATE, G, (int)blockIdx.x);
            pg8::EpiAct<0> E{(pg8::bf16_t*)(P.ws + WS_GATES), NGATE, SSQ};
            pg8::gemm_phase<pg8::EpiAct<0>, pg8::StaticOrder, true, true>(lds, g, S, E, wave0);
            SEAM(pb + 3);
        }
        if (IN(pb + 4)) {
            pg8::Gemm g{(const pg8::bf16_t*)(P.ws + WS_O), (const pg8::bf16_t*)(P.ws + WS_WM), TOK, DM, KMERGE}; pg8::StaticOrder S; S.init(TOK, DM, G, (int)blockIdx.x);
            pg8::EpiMerge E{(const pg8::bf16_t*)(P.ws + WS_GATES), (pg8::bf16_t*)(P.ws + WS_MERGED)};
            pg8::gemm_phase<pg8::EpiMerge, pg8::StaticOrder, true, true>(lds, g, S, E, wave0);
            SEAM(pb + 4);
        }
        if (IN(pb + 5)) {
            pg8::Gemm g{(const pg8::bf16_t*)(P.ws + WS_MERGED), (const pg8::bf16_t*)(P.ws + WS_WO), TOK, DM, DM}; pg8::StaticOrder S; S.init(TOK, DM, G, (int)blockIdx.x);
            pg8::EpiResid E{(pg8::bf16_t*)(P.ws + WS_HB), SSQ};
            pg8::gemm_phase<pg8::EpiResid, pg8::StaticOrder, true, true>(lds, g, S, E, wave0);
            SEAM(pb + 5);
        }
        if (IN(pb + 6)) {
            pg8::Gemm g{HB, (const pg8::bf16_t*)(P.ws + WS_WUP), TOK, FF, DM}; pg8::StaticOrder S; S.init(TOK, FF, G, (int)blockIdx.x);
            pg8::EpiAct<1> E{(pg8::bf16_t*)(P.ws + WS_HID), FF, SSQ};
            pg8::gemm_phase<pg8::EpiAct<1>, pg8::StaticOrder, true, true>(lds, g, S, E, wave0);
            SEAM(pb + 6);
        }
        if (IN(pb + 7)) {
            pg8::Gemm g{(const pg8::bf16_t*)(P.ws + WS_HID), (const pg8::bf16_t*)(P.ws + WS_WDN), TOK, DM, FF}; pg8::StaticOrder S; S.init(TOK, DM, G, (int)blockIdx.x);
            pg8::EpiResid E{(pg8::bf16_t*)(P.ws + WS_HB), SSQ};
            pg8::gemm_phase<pg8::EpiResid, pg8::StaticOrder, true, true>(lds, g, S, E, wave0);
            SEAM(pb + 7);
        }
    }
    if (IN(18)) { PHASE_IDS(); final_norm_rows(P, wave, lane); }
    if (PROBE_PHASE >= 0 && blockIdx.x == 0 && threadIdx.x == 0) {
        volatile LAS unsigned long long* ts = (volatile LAS unsigned long long*)(lds + LDSCTL_OFF + 1024);
        const unsigned long long span = PROBE_PHASE >= 100 ? ((volatile LAS unsigned long long*)(lds + LDSCTL_OFF + 2048))[PROBE_PHASE - 100] : ts[PROBE_PHASE + 1] - ts[PROBE_PHASE], t0 = __builtin_amdgcn_s_memrealtime();
        while (__builtin_amdgcn_s_memrealtime() - t0 < 4ull * span) __builtin_amdgcn_s_sleep(8);
    }
#undef IN
#undef SEAM
}

extern "C" void kernel_launch(void* const* d_in, const int* in_sizes, int n_in, void* d_out, int out_size, void* d_ws, size_t ws_size, hipStream_t stream) {
    static int grid = 0;
    if (grid == 0) {
        if (n_in != 14 || in_sizes[0] != TOK * DM || out_size != TOK * DM || ws_size < WS_END) {
            fprintf(stderr, "kernel_launch: built for 14 inputs, x/out of %d floats, >= %zu bytes of workspace; got n_in %d, in0 %d, out %d, ws %zu; nothing launched\n", TOK * DM, (size_t)WS_END, n_in, n_in > 0 ? in_sizes[0] : -1, out_size, ws_size);
            grid = -1; return; }
        int dev = 0, cus = 0, per_cu = 0;
        if (hipGetDevice(&dev) != hipSuccess || hipDeviceGetAttribute(&cus, hipDeviceAttributeMultiprocessorCount, dev) != hipSuccess) { grid = -1; return; }
        if (hipFuncSetAttribute((const void*)hybrid_fwd, hipFuncAttributeMaxDynamicSharedMemorySize, LDS_BYTES) != hipSuccess) { fprintf(stderr, "kernel_launch: hipFuncSetAttribute failed\n"); grid = -1; return; }
        if (hipOccupancyMaxActiveBlocksPerMultiprocessor(&per_cu, (const void*)hybrid_fwd, NWAVES * 64, LDS_BYTES) != hipSuccess || per_cu < 1) { fprintf(stderr, "kernel_launch: occupancy query says %d blocks per CU\n", per_cu); grid = -1; (void)hipGetLastError(); return; }
        (void)hipGetLastError();
        grid = cus;
        if (grid > 256) grid = 256;
    }
    if (grid < 0) return;
    if (hipMemsetAsync((char*)d_ws + WS_CTL, 0, CTL_ZERO_BYTES, stream) != hipSuccess) return;
    Args a{};
    a.p.x = (const float*)d_in[0]; a.p.pos = (const int*)d_in[1]; a.p.attn_norm = (const float*)d_in[2]; a.p.w_in = (const float*)d_in[3]; a.p.iknorm = (const float*)d_in[4];
    a.p.sinks = (const float*)d_in[5]; a.p.w_a = (const float*)d_in[6]; a.p.w_b = (const float*)d_in[7]; a.p.w_c = (const float*)d_in[8]; a.p.w_o = (const float*)d_in[9];
    a.p.mlp_norm = (const float*)d_in[10]; a.p.w_up = (const float*)d_in[11]; a.p.w_down = (const float*)d_in[12]; a.p.final_norm = (const float*)d_in[13];
    a.p.out = (float*)d_out; a.p.ws = (unsigned char*)d_ws;
#if MK_ONE_LAUNCH
    a.ph_lo = 0; a.ph_hi = N_PHASES;
    hipLaunchKernelGGL(hybrid_fwd, dim3(grid), dim3(NWAVES * 64), LDS_BYTES, stream, a);
#else
    for (int ph = 0; ph < N_PHASES; ++ph) { a.ph_lo = ph; a.ph_hi = ph + 1; hipLaunchKernelGGL(hybrid_fwd, dim3(grid), dim3(NWAVES * 64), LDS_BYTES, stream, a); }
#endif
}
```
